# Optimizing an MI355X kernel written in HIP

```python
import math
import jax
import jax.numpy as jnp
from jax import lax
import numpy as np

D_MODEL = 1024
BATCH = 16
SEQ = 256
DEPTH = 2
DEC_BATCH = 2
DEC_SEQ = 4096
PAST_LEN = 256

GRID_W = 64
ROPE_BASE = 10000.0
EPS = 1e-6
Q_BLOCK = 128
H_M = 4
DK_M = 64
DV_M = 128
MLSTM_CHUNK = 64
F_BIAS = 3.0
H_A = 8
Q_RANK = 384
KV_RANK = 256
NOPE_A = 64
ROPE_A = 32
V_A = 64
H_D = 4
DK_D = 64
DV_D = 128
D_FF = 4 * D_MODEL
IN_SPLITS = (H_M * DK_M, H_M * DK_M, H_M * DV_M, H_M * DV_M, 4 * H_M,
             Q_RANK, KV_RANK, ROPE_A,
             H_D * 2 * DK_D, H_D * 2 * DK_D, H_D * DV_D,
             3 * D_MODEL)
IN_COLS = (2 * H_M * DK_M + 2 * H_M * DV_M + 4 * H_M + Q_RANK + KV_RANK + ROPE_A
           + 4 * H_D * DK_D + H_D * DV_D + 3 * D_MODEL)

kernel_name = "hybrid_mlstm_mla_diffattn_dit_step"


def _rms(x, g):
    xf = x.astype(jnp.float32)
    y = xf * lax.rsqrt(jnp.mean(xf * xf, axis=-1, keepdims=True) + EPS)
    return (y * g.astype(jnp.float32)).astype(x.dtype)


def _rev(a):
    return jnp.flip(a, axis=1)


def _axial_tables(n_tokens, dim):
    rows = n_tokens // GRID_W
    row = jnp.repeat(jnp.arange(rows, dtype=jnp.float32), GRID_W)
    col = jnp.tile(jnp.arange(GRID_W, dtype=jnp.float32), rows)
    quarter = dim // 4
    inv = ROPE_BASE ** (-jnp.arange(quarter, dtype=jnp.float32) / quarter)
    ang = jnp.concatenate([row[:, None] * inv, col[:, None] * inv], axis=-1)
    return jnp.cos(ang), jnp.sin(ang)


def _rope(x, cos, sin):
    half = x.shape[-1] // 2
    shape = (x.shape[1],) + (1,) * (x.ndim - 3) + (half,)
    c = cos.reshape(shape).astype(x.dtype)
    s = sin.reshape(shape).astype(x.dtype)
    x1, x2 = x[..., :half], x[..., half:]
    return jnp.concatenate([x1 * c - x2 * s, x1 * s + x2 * c], axis=-1)


def _attend(q, k, v, q2=None, k2=None, lam=None):
    B, S, H, d = q.shape
    nb = S // Q_BLOCK
    scale = d ** -0.5

    def blocks(a):
        return jnp.swapaxes(a.reshape((B, nb, Q_BLOCK) + a.shape[2:]), 0, 1)

    def probs(qb, kk):
        s = jnp.einsum("bqhd,bkhd->bhqk", qb, kk).astype(jnp.float32) * scale
        return jax.nn.softmax(s, axis=-1)

    def one(qbs):
        p = probs(qbs[0], k)
        if q2 is not None:
            p = p - lam * probs(qbs[1], k2)
        return jnp.einsum("bhqk,bkhe->bqhe", p.astype(v.dtype), v)

    qs = (blocks(q),) if q2 is None else (blocks(q), blocks(q2))
    o = lax.map(one, qs)
    return jnp.swapaxes(o, 0, 1).reshape(B, S, H, v.shape[-1])


def _mlstm_chunk(carry, xs):
    C, n, m = carry
    q, k, v, log_i, log_f = xs
    L = q.shape[1]
    b = jnp.cumsum(log_f, axis=1).transpose(0, 2, 1)
    li = log_i.transpose(0, 2, 1)
    causal = jnp.tril(jnp.ones((L, L), dtype=bool))
    dmat = jnp.where(causal, b[..., :, None] - b[..., None, :] + li[..., None, :], -jnp.inf)
    inter = b + m[..., None]
    m_t = jnp.maximum(inter, jnp.max(dmat, axis=-1))
    w_inter = jnp.exp(inter - m_t)
    a = jnp.exp(dmat - m_t[..., None]) * jnp.einsum("blhd,bshd->bhls", q, k)
    num = w_inter[..., None] * jnp.einsum("blhd,bhde->bhle", q, C) + jnp.einsum("bhls,bshe->bhle", a, v)
    den = w_inter * jnp.einsum("blhd,bhd->bhl", q, n) + jnp.sum(a, axis=-1)
    h = num / jnp.maximum(jnp.abs(den), jnp.exp(-m_t))[..., None]
    m_new = m_t[..., -1]
    w_old = jnp.exp(b[..., -1] + m - m_new)
    w_s = jnp.exp(b[..., -1:] - b + li - m_new[..., None])
    C_new = w_old[..., None, None] * C + jnp.einsum("bhs,bshd,bshe->bhde", w_s, k, v)
    n_new = w_old[..., None] * n + jnp.einsum("bhs,bshd->bhd", w_s, k)
    return (C_new, n_new, m_new), h.transpose(0, 2, 1, 3)


def _mlstm_scan(q, k, v, log_i, log_f, state):
    B, S = q.shape[:2]
    nc = S // MLSTM_CHUNK

    def chunks(a):
        return jnp.swapaxes(a.reshape((B, nc, MLSTM_CHUNK) + a.shape[2:]), 0, 1)

    state, h = lax.scan(_mlstm_chunk, state,
                        (chunks(q), chunks(k), chunks(v), chunks(log_i), chunks(log_f)))
    return jnp.swapaxes(h, 0, 1).reshape(B, S, H_M, DV_M), state


def _layer(x, cond, lp, lam_init, ctx):
    B, N, _ = x.shape
    dt = x.dtype
    f32 = jnp.float32
    latent = ctx is not None
    mod = jax.nn.silu(cond) @ lp["w_mod"] + lp["b_mod"]
    sh1, sc1, g1, sh2, sc2, g2 = jnp.split(mod[:, None, :], 6, axis=-1)
    h = _rms(x, lp["norm1_g"]) * (1.0 + sc1) + sh1
    z = h @ lp["w_in"]
    (mq, mk, mv, mo, mg, acq, ackv, akr, dq, dk, dv, gate_pre) = jnp.split(
        z, np.cumsum(IN_SPLITS)[:-1].tolist(), axis=-1)
    if latent:
        cos_a, sin_a = _axial_tables(N, ROPE_A)
        cos_d, sin_d = _axial_tables(N, DK_D)

    if latent:
        C0, n0, m0 = ctx[4].astype(f32), ctx[5].astype(f32), ctx[6].astype(f32)
    else:
        C0 = jnp.zeros((B, 2, H_M, DK_M, DV_M), f32)
        n0 = jnp.zeros((B, 2, H_M, DK_M), f32)
        m0 = jnp.zeros((B, 2, H_M), f32)
    q_m = mq.reshape(B, N, H_M, DK_M).astype(f32) * DK_M ** -0.5
    k_m = mk.reshape(B, N, H_M, DK_M).astype(f32)
    v_m = mv.reshape(B, N, H_M, DV_M).astype(f32)
    gp = (mg + lp["mlstm_gate_b"]).astype(f32).reshape(B, N, 2, 2, H_M)
    log_i = gp[:, :, 0]
    log_f = jax.nn.log_sigmoid(gp[:, :, 1])
    h_f, (Cf, nf, mf) = _mlstm_scan(q_m, k_m, v_m, log_i[:, :, 0], log_f[:, :, 0],
                                    (C0[:, 0], n0[:, 0], m0[:, 0]))
    h_b, (Cb, nb, mb) = _mlstm_scan(_rev(q_m), _rev(k_m), _rev(v_m), _rev(log_i[:, :, 1]),
                                    _rev(log_f[:, :, 1]), (C0[:, 1], n0[:, 1], m0[:, 1]))
    h_m = (h_f + _rev(h_b)).astype(dt)
    o_m = _rms(h_m, lp["mlstm_norm_g"].reshape(H_M, DV_M)).reshape(B, N, H_M * DV_M) * jax.nn.sigmoid(mo)

    q_a = (_rms(acq, lp["mla_q_norm_g"]) @ lp["mla_w_q_up"]).reshape(B, N, H_A, NOPE_A + ROPE_A)
    q_nope, q_rope = q_a[..., :NOPE_A], q_a[..., NOPE_A:]
    ckv = _rms(ackv, lp["mla_kv_norm_g"])
    if latent:
        q_rope = _rope(q_rope, cos_a, sin_a)
        ckv_all = jnp.concatenate([ctx[0], ckv], axis=1)
        kr_all = jnp.concatenate([ctx[1], _rope(akr[:, :, None, :], cos_a, sin_a)[:, :, 0]], axis=1)
    else:
        ckv_all, kr_all = ckv, akr
    T = ckv_all.shape[1]
    kv = (ckv_all @ lp["mla_w_kv_up"]).reshape(B, T, H_A, NOPE_A + V_A)
    k_a = jnp.concatenate([kv[..., :NOPE_A],
                           jnp.broadcast_to(kr_all[:, :, None, :], (B, T, H_A, ROPE_A))], axis=-1)
    o_a = _attend(jnp.concatenate([q_nope, q_rope], axis=-1), k_a, kv[..., NOPE_A:]).reshape(B, N, H_A * V_A)

    q_d = dq.reshape(B, N, H_D, 2, DK_D)
    k_d = dk.reshape(B, N, H_D, 2, DK_D)
    v_d = dv.reshape(B, N, H_D, DV_D)
    if latent:
        q_d = _rope(q_d, cos_d, sin_d)
        k_all = jnp.concatenate([ctx[2].reshape(B, ctx[2].shape[1], H_D, 2, DK_D),
                                 _rope(k_d, cos_d, sin_d)], axis=1)
        v_all = jnp.concatenate([ctx[3], v_d], axis=1)
    else:
        k_all, v_all = k_d, v_d
    lam_v = lp["diff_lambda"].astype(f32)
    lam = jnp.exp(jnp.sum(lam_v[0] * lam_v[1])) - jnp.exp(jnp.sum(lam_v[2] * lam_v[3])) + lam_init
    o_d = _attend(q_d[..., 0, :], k_all[..., 0, :], v_all, q_d[..., 1, :], k_all[..., 1, :], lam)
    o_d = (_rms(o_d, lp["diff_norm_g"].reshape(H_D, DV_D)) * (1.0 - lam_init)).reshape(B, N, H_D * DV_D)

    g_m, g_a, g_d = jnp.split(jax.nn.sigmoid(gate_pre), 3, axis=-1)
    y = (g_m * (o_m @ lp["w_br_mlstm"]) + g_a * (o_a @ lp["w_br_mla"])
         + g_d * (o_d @ lp["w_br_diff"]))
    x = x + g1 * (y @ lp["w_out"])

    h2 = _rms(x, lp["norm2_g"]) * (1.0 + sc2) + sh2
    x = x + g2 * (jnp.square(jax.nn.relu(h2 @ lp["w_ff1"])) @ lp["w_ff2"])
    if latent:
        return x, None
    new_ctx = (ckv, akr, k_d.reshape(B, N, H_D, 2 * DK_D), v_d,
               jnp.stack([Cf, Cb], axis=1).astype(dt),
               jnp.stack([nf, nb], axis=1).astype(dt),
               jnp.stack([mf, mb], axis=1).astype(dt))
    return x, new_ctx


def setup_inputs(seed: int = 0) -> dict:
    key = jax.random.key(seed)
    ks = iter(jax.random.split(key, 40))

    def nrm(shape, scale=1.0):
        return scale * jax.random.normal(next(ks), shape, jnp.float32)

    def gain(shape):
        return 1.0 + 0.02 * nrm(shape)

    return {
        "x_prompt": nrm((BATCH, SEQ, D_MODEL)),
        "x_sample": nrm((DEC_BATCH, DEC_SEQ, D_MODEL)),
        "c": nrm((DEC_BATCH, D_MODEL)),
        "cache_mla_ckv": nrm((DEC_BATCH, DEPTH, PAST_LEN, KV_RANK)),
        "cache_mla_krope": nrm((DEC_BATCH, DEPTH, PAST_LEN, ROPE_A)),
        "cache_diff_k": nrm((DEC_BATCH, DEPTH, PAST_LEN, H_D, 2 * DK_D)),
        "cache_diff_v": nrm((DEC_BATCH, DEPTH, PAST_LEN, H_D, DV_D)),
        "state_mlstm_C": nrm((DEC_BATCH, DEPTH, 2, H_M, DK_M, DV_M), 0.5),
        "state_mlstm_n": nrm((DEC_BATCH, DEPTH, 2, H_M, DK_M), 0.5),
        "state_mlstm_m": nrm((DEC_BATCH, DEPTH, 2, H_M), 0.5),
        "c_ctx": nrm((D_MODEL,)),
        "w_mod": nrm((DEPTH, D_MODEL, 6 * D_MODEL), 0.5 * D_MODEL ** -0.5),
        "b_mod": nrm((DEPTH, 6 * D_MODEL), 0.02),
        "norm1_g": gain((DEPTH, D_MODEL)),
        "w_in": nrm((DEPTH, D_MODEL, IN_COLS), D_MODEL ** -0.5),
        "mlstm_gate_b": jnp.concatenate([nrm((DEPTH, 2 * H_M), 0.1),
                                         F_BIAS + nrm((DEPTH, 2 * H_M), 0.1)], axis=-1),
        "mlstm_norm_g": gain((DEPTH, H_M * DV_M)),
        "mla_q_norm_g": gain((DEPTH, Q_RANK)),
        "mla_w_q_up": nrm((DEPTH, Q_RANK, H_A * (NOPE_A + ROPE_A)), Q_RANK ** -0.5),
        "mla_kv_norm_g": gain((DEPTH, KV_RANK)),
        "mla_w_kv_up": nrm((DEPTH, KV_RANK, H_A * (NOPE_A + V_A)), KV_RANK ** -0.5),
        "diff_lambda": nrm((DEPTH, 4, DK_D), 0.1),
        "diff_norm_g": gain((DEPTH, H_D * DV_D)),
        "w_br_mlstm": nrm((DEPTH, H_M * DV_M, D_MODEL), (H_M * DV_M) ** -0.5),
        "w_br_mla": nrm((DEPTH, H_A * V_A, D_MODEL), (H_A * V_A) ** -0.5),
        "w_br_diff": nrm((DEPTH, H_D * DV_D, D_MODEL), (H_D * DV_D) ** -0.5),
        "w_out": nrm((DEPTH, D_MODEL, D_MODEL), D_MODEL ** -0.5),
        "norm2_g": gain((DEPTH, D_MODEL)),
        "w_ff1": nrm((DEPTH, D_MODEL, D_FF), D_MODEL ** -0.5),
        "w_ff2": nrm((DEPTH, D_FF, D_MODEL), D_FF ** -0.5),
        "final_norm_g": gain((D_MODEL,)),
    }


def reference(x_prompt, x_sample, c, cache_mla_ckv, cache_mla_krope, cache_diff_k, cache_diff_v,
              state_mlstm_C, state_mlstm_n, state_mlstm_m, c_ctx, w_mod, b_mod, norm1_g, w_in,
              mlstm_gate_b, mlstm_norm_g, mla_q_norm_g, mla_w_q_up, mla_kv_norm_g, mla_w_kv_up,
              diff_lambda, diff_norm_g, w_br_mlstm, w_br_mla, w_br_diff, w_out, norm2_g, w_ff1, w_ff2,
              final_norm_g):
    y_p = x_prompt
    y_s = x_sample
    cond_ctx = c_ctx[None, :]
    st = ([], [], [], [], [], [], [])
    for l in range(DEPTH):
        lp = {
            "w_mod": w_mod[l], "b_mod": b_mod[l], "norm1_g": norm1_g[l], "w_in": w_in[l],
            "mlstm_gate_b": mlstm_gate_b[l], "mlstm_norm_g": mlstm_norm_g[l],
            "mla_q_norm_g": mla_q_norm_g[l], "mla_w_q_up": mla_w_q_up[l],
            "mla_kv_norm_g": mla_kv_norm_g[l], "mla_w_kv_up": mla_w_kv_up[l],
            "diff_lambda": diff_lambda[l], "diff_norm_g": diff_norm_g[l],
            "w_br_mlstm": w_br_mlstm[l], "w_br_mla": w_br_mla[l], "w_br_diff": w_br_diff[l],
            "w_out": w_out[l], "norm2_g": norm2_g[l], "w_ff1": w_ff1[l], "w_ff2": w_ff2[l],
        }
        lam_init = 0.8 - 0.6 * math.exp(-0.3 * l)
        y_p, ctx_new = _layer(y_p, cond_ctx, lp, lam_init, None)
        for lst, a in zip(st, ctx_new):
            lst.append(a)
        ctx_l = (cache_mla_ckv[:, l], cache_mla_krope[:, l], cache_diff_k[:, l], cache_diff_v[:, l],
                 state_mlstm_C[:, l], state_mlstm_n[:, l], state_mlstm_m[:, l])
        y_s, _ = _layer(y_s, c, lp, lam_init, ctx_l)
    y_prompt = _rms(y_p, final_norm_g)
    y_sample = _rms(y_s, final_norm_g)
    new_mla_ckv = jnp.stack(st[0], axis=1)
    new_mla_krope = jnp.stack(st[1], axis=1)
    new_diff_k = jnp.stack(st[2], axis=1)
    new_diff_v = jnp.stack(st[3], axis=1)
    new_mlstm_C = jnp.stack(st[4], axis=1)
    new_mlstm_n = jnp.stack(st[5], axis=1)
    new_mlstm_m = jnp.stack(st[6], axis=1)
    return (y_prompt, y_sample, new_mla_ckv, new_mla_krope, new_diff_k, new_diff_v,
            new_mlstm_C, new_mlstm_n, new_mlstm_m)
```

```cpp
#include <hip/hip_runtime.h>
#include <cstdio>
#include <cstdint>

#define GAS __attribute__((address_space(1)))
#define LAS __attribute__((address_space(3)))
typedef unsigned short bf16_t;
typedef float f32x4 __attribute__((ext_vector_type(4)));
typedef float f32x2 __attribute__((ext_vector_type(2)));
typedef unsigned u32x4 __attribute__((ext_vector_type(4)));
typedef unsigned u32x2 __attribute__((ext_vector_type(2)));
typedef short bf16x8 __attribute__((ext_vector_type(8)));
typedef GAS unsigned gu32;
#define RLX_AGENT __ATOMIC_RELAXED, __HIP_MEMORY_SCOPE_AGENT

constexpr int D = 1024, DFF = 4096, DEPTH = 2;
constexpr int CB = 16, CS = 256, LB = 2, LS = 4096, PAST = 256;
constexpr int NCTX = CB * CS, NLAT = LB * LS, M = NCTX + NLAT;
constexpr int LT = PAST + LS;
constexpr int KROWS = NCTX + LB * LT;
constexpr int INC = 6832;
constexpr int ZN = 3840, GN = 3072, WINROWS = ZN + GN;
constexpr int HM = 4, DKM = 64, DVM = 128;
constexpr int HA = 8, QR = 384, KVR = 256, NOPE = 64, ROPA = 32, VA = 64, QKA = NOPE + ROPA;
constexpr int HD = 4, DKD = 64, DVD = 128;
constexpr float EPS = 1e-6f;
constexpr int NWAVES = 8, NTHR = 512;

constexpr size_t WS_CTL = 0, CTL_BYTES = 1u << 20;
constexpr size_t WS_SMALL = WS_CTL + CTL_BYTES;
constexpr size_t SMALL_BYTES = 256 * 1024;
constexpr size_t WS_WIN = WS_SMALL + SMALL_BYTES;
constexpr size_t WS_WQ = WS_WIN + (size_t)WINROWS * D * 2;
constexpr size_t WS_WKVG = WS_WQ + (size_t)768 * QR * 2;
constexpr size_t WS_WKV = WS_WKVG + (size_t)1024 * KVR * 2;
constexpr size_t WS_WBM = WS_WKV + (size_t)1024 * KVR * 2;
constexpr size_t WS_WBA = WS_WBM + (size_t)D * 512 * 2;
constexpr size_t WS_WBD = WS_WBA + (size_t)D * 512 * 2;
constexpr size_t WS_WOUT = WS_WBD + (size_t)D * 512 * 2;
constexpr size_t WS_W1 = WS_WOUT + (size_t)D * D * 2;
constexpr size_t WS_W2 = WS_W1 + (size_t)DFF * D * 2;
constexpr size_t WS_H = WS_W2 + (size_t)D * DFF * 2;
constexpr size_t WS_MQKVO = WS_H + (size_t)M * D * 2;
constexpr size_t WS_DQ = WS_MQKVO + (size_t)M * 1536 * 2;
constexpr size_t WS_ACQ = WS_DQ + (size_t)M * 512 * 2;
constexpr size_t WS_ACKV = WS_ACQ + (size_t)M * QR * 2;
constexpr size_t WS_DK = WS_ACKV + (size_t)M * KVR * 2;
constexpr size_t WS_DV = WS_DK + (size_t)KROWS * 512 * 2;
constexpr size_t WS_QA = WS_DV + (size_t)KROWS * 512 * 2;
constexpr int KVP = 1056;
constexpr size_t WS_KV = WS_QA + (size_t)M * 768 * 2;
constexpr size_t WS_BLK_END = WS_KV + (size_t)KROWS * KVP * 2;
constexpr size_t WS_GATES = WS_ACQ;
static_assert(WS_GATES + (size_t)M * GN * 2 <= WS_BLK_END, "gates overlay");
constexpr size_t WS_U = WS_MQKVO;
static_assert(WS_U + (size_t)M * DFF * 2 <= WS_BLK_END, "u overlay");
constexpr size_t WS_CKVC = WS_BLK_END;
constexpr size_t WS_MG = WS_CKVC + (size_t)512 * 256 * 2;
constexpr size_t WS_OA = WS_MG + (size_t)M * 16 * 4;
constexpr size_t WS_OM = WS_OA + (size_t)M * 512 * 2;
constexpr size_t WS_HF = WS_OM + (size_t)M * 512 * 2;
constexpr size_t WS_HB = WS_HF + (size_t)M * 512 * 2;
constexpr size_t WS_DEN = WS_HB + (size_t)M * 512 * 2;
constexpr int ML_NSEG = 16, ML_SEGCH = (LS / 64) / ML_NSEG;
constexpr int SLAB_F = 2048 + 64;
constexpr size_t WS_SLAB = WS_DEN + (size_t)M * 8 * 4;
constexpr size_t WS_END = WS_SLAB + (size_t)(LB * 2 * HM) * 5 * ML_NSEG * SLAB_F * 4;
static_assert(WS_END <= 268435456, "workspace must fit 256 MiB");
constexpr int CW_BAR = 4096;
constexpr int CW_QUEUE = 16384;
constexpr int CW_SSQ = 32768;
constexpr int CW_SSKV = CW_SSQ + DEPTH * M;
static_assert((size_t)(CW_SSKV + DEPTH * M) * 4 <= CTL_BYTES, "ctl");
constexpr int SM_MOD = 0;
constexpr int SM_TD = SM_MOD + DEPTH * 3 * 6 * D;
constexpr int SM_TA = SM_TD + 64 * 16 * 2;
constexpr int SM_LAM = SM_TA + 64 * 8 * 2;
static_assert((size_t)(SM_LAM + 8) * 4 <= SMALL_BYTES, "small");
constexpr size_t O_X = 0;
constexpr size_t O_CKV = (size_t)M * D;
constexpr size_t O_KROPE = O_CKV + (size_t)CB * DEPTH * CS * KVR;
constexpr size_t O_DK = O_KROPE + (size_t)CB * DEPTH * CS * ROPA;
constexpr size_t O_DV = O_DK + (size_t)CB * DEPTH * CS * 512;
constexpr size_t O_C = O_DV + (size_t)CB * DEPTH * CS * 512;
constexpr size_t O_N = O_C + (size_t)CB * DEPTH * 2 * HM * DKM * DVM;
constexpr size_t O_M = O_N + (size_t)CB * DEPTH * 2 * HM * DKM;
constexpr size_t O_END = O_M + (size_t)CB * DEPTH * 2 * HM;

constexpr int RING_BYTES = 131072;
constexpr int LDSCTL_OFF = RING_BYTES, MISC_OFF = LDSCTL_OFF + 320;
constexpr int LDS_BYTES = 147456;

__device__ __forceinline__ float bf2f(bf16_t v) { return __uint_as_float((unsigned)v << 16); }
__device__ __forceinline__ unsigned f2bf(float f) { unsigned u = __float_as_uint(f); return (u + 0x7fffu + ((u >> 16) & 1u)) >> 16; }
typedef float f32x2_ __attribute__((ext_vector_type(2))); typedef __bf16 bf16x2_ __attribute__((ext_vector_type(2)));
__device__ __forceinline__ unsigned pk2(float lo, float hi) { f32x2_ v = {lo, hi}; bf16x2_ b = __builtin_convertvector(v, bf16x2_); return __builtin_bit_cast(unsigned, b); }
__device__ __forceinline__ float lo_bf(unsigned w) { return __uint_as_float(w << 16); }
__device__ __forceinline__ float hi_bf(unsigned w) { return __uint_as_float(w & 0xffff0000u); }
__device__ __forceinline__ float sigmoidf_(float x) { return 1.f / (1.f + expf(-x)); }
__device__ __forceinline__ float logsigmoidf_(float x) { return fminf(x, 0.f) - log1pf(expf(-fabsf(x))); }
__device__ __forceinline__ float lane_xor(float v, int mask, int lane) { return __int_as_float(__builtin_amdgcn_ds_bpermute((lane ^ mask) << 2, __float_as_int(v))); }
__device__ __forceinline__ float lane_up(float v, int d, int lane) { return __int_as_float(__builtin_amdgcn_ds_bpermute((lane - d) << 2, __float_as_int(v))); }
__device__ __forceinline__ float wave_sum(float v, int lane) {
#pragma unroll
    for (int o = 1; o < 64; o <<= 1) v += lane_xor(v, o, lane);
    return v;
}
__device__ __forceinline__ int keyrow_of(int row) { if (row < NCTX) return row; const int r = row - NCTX; return NCTX + (r >> 12) * LT + PAST + (r & 4095); }
__device__ __forceinline__ int rg_of(int row) { return row < NCTX ? 0 : 1 + ((row - NCTX) >> 12); }

#define XB_TMO      128
#define XB_XCNT(j)  (256  + 64 * (j))
#define XB_XSUB(j)  (1280 + 64 * (j))
#define XB_XGEN(j)  (2304 + 64 * (j))
#define XB_TOP      3328
#define XB_TOPGEN   3392
#define XCD_BAR_WORDS 3456
#define XB_SPIN_CAP (1u << 22)
__device__ __forceinline__ unsigned xb_ld(unsigned* p)              { return __hip_atomic_load(p, __ATOMIC_RELAXED, __HIP_MEMORY_SCOPE_AGENT); }
__device__ __forceinline__ unsigned xb_add(unsigned* p, unsigned v) { return __hip_atomic_fetch_add(p, v, __ATOMIC_RELAXED, __HIP_MEMORY_SCOPE_AGENT); }
__device__ __forceinline__ unsigned xb_xcc_id() { return (unsigned)__builtin_amdgcn_s_getreg((3 << 11) | 20) & 0xFu; }
#define XB_SPIN(cond, bar) do { unsigned _sp = 0; while (cond) { __builtin_amdgcn_s_sleep(1); \
    if ((++_sp & 255u) == 0u) { if (xb_ld(&(bar)[XB_TMO])) break; if (_sp > XB_SPIN_CAP) { atomicAdd(&(bar)[XB_TMO], 1u); break; } } } } while (0)
struct XcdBarrier { unsigned* bar; unsigned x; volatile LAS unsigned* st; };
__device__ __forceinline__ XcdBarrier xcd_barrier_post(unsigned* bar, volatile LAS unsigned* st) {
    XcdBarrier b; b.bar = bar; b.x = xb_xcc_id(); b.st = st;
    if (threadIdx.x == 0) (void)xb_add(&bar[XB_XCNT(b.x)], 1u);
    return b;
}
__device__ __forceinline__ void xcd_barrier_complete(unsigned* bar, unsigned x, unsigned& nloc, unsigned& nx) {
    const unsigned G = gridDim.x * gridDim.y * gridDim.z;
    unsigned sum, cnt, mine, sp = 0u;
    for (;;) {
        sum = 0u; cnt = 0u; mine = 0u;
#pragma unroll
        for (unsigned j = 0; j < 16; ++j) { const unsigned c = xb_ld(&bar[XB_XCNT(j)]); sum += c; cnt += (c > 0u) ? 1u : 0u; mine = (j == x) ? c : mine; }
        if (sum == G) break;
        __builtin_amdgcn_s_sleep(1);
        if ((++sp & 255u) == 0u) { if (xb_ld(&bar[XB_TMO])) break; if (sp > XB_SPIN_CAP) { atomicAdd(&bar[XB_TMO], 1u); break; } }
    }
    nloc = mine > 0u ? mine : 1u; nx = cnt > 0u ? cnt : 1u;
}
__device__ __forceinline__ void xcd_barrier(const XcdBarrier& b) {
    asm volatile("s_waitcnt vmcnt(0)" ::: "memory");
    __syncthreads();
    if (threadIdx.x == 0) {
        unsigned* bar = b.bar;
        __builtin_amdgcn_s_waitcnt(0);
        unsigned nloc = b.st[0], nx = b.st[1];
        if (nloc == 0u) { xcd_barrier_complete(bar, b.x, nloc, nx); b.st[0] = nloc; b.st[1] = nx; }
        const unsigned old = xb_add(&bar[XB_XSUB(b.x)], 1u);
        const unsigned gen = old / nloc;
        if (old + 1u == (gen + 1u) * nloc) {
            __builtin_amdgcn_fence(__ATOMIC_RELEASE, "agent");
            asm volatile("s_waitcnt vmcnt(0)" ::: "memory");
            const unsigned og = xb_add(&bar[XB_TOP], 1u);
            const unsigned tg = og / nx;
            if (og + 1u == (tg + 1u) * nx) xb_add(&bar[XB_TOPGEN], 1u);
            else XB_SPIN(xb_ld(&bar[XB_TOPGEN]) == tg, bar);
            __builtin_amdgcn_fence(__ATOMIC_ACQUIRE, "agent");
            xb_add(&bar[XB_XGEN(b.x)], 1u);
            asm volatile("s_waitcnt vmcnt(0)" ::: "memory");
        } else {
            XB_SPIN(xb_ld(&bar[XB_XGEN(b.x)]) == gen, bar);
            __builtin_amdgcn_fence(__ATOMIC_ACQUIRE, "agent");
            asm volatile("s_waitcnt vmcnt(0)" ::: "memory");
        }
    }
    __syncthreads();
}

template <class T> __device__ __forceinline__ T* opaque_ptr(T* p) {
    unsigned lo = (unsigned)(uintptr_t)p, hi = (unsigned)((uintptr_t)p >> 32); asm volatile("" : "+v"(lo), "+v"(hi));
    lo = __builtin_amdgcn_readfirstlane(lo); hi = __builtin_amdgcn_readfirstlane(hi);
    return (T*)(__attribute__((address_space(1))) T*)(((uintptr_t)hi << 32) | (uintptr_t)lo);
}
__device__ __forceinline__ int opaque_int(int x) { asm volatile("" : "+v"(x)); return __builtin_amdgcn_readfirstlane(x); }
struct Args { const float* in[31]; float* out; unsigned char* ws; int ph_lo, ph_hi, li, pad; };
enum { I_XP = 0, I_XS, I_C, I_CCKV, I_CKR, I_CDK, I_CDV, I_SC, I_SN, I_SM, I_CCTX, I_WMOD, I_BMOD, I_N1G, I_WIN, I_GATEB, I_MNG, I_QNG, I_WQUP, I_KVNG, I_WKVUP,
       I_LAMBDA, I_DNG, I_WBM, I_WBA, I_WBD, I_WOUT, I_N2G, I_WFF1, I_WFF2, I_FNG };

struct Frame {
    LAS unsigned char* lds;
    int tid, lane, wave, G, bid;
    const __attribute__((address_space(4))) Args* ka;
    float* out; unsigned char* ws;
    __device__ __forceinline__ const float* inp(int i) const { return (const float*)(const __attribute__((address_space(1))) float*)ka->in[i]; }
    __device__ __forceinline__ float* smallf() const { return (float*)(ws + WS_SMALL); }
    __device__ __forceinline__ gu32* ctl() const { return (gu32*)(ws + WS_CTL); }
    template <class T> __device__ __forceinline__ T* wsp(size_t off) const { return (T*)(ws + off); }
    __device__ __forceinline__ const float* mod(int l, int rg, int chunk) const { return smallf() + SM_MOD + ((l * 3 + rg) * 6 + chunk) * D; }
    __device__ __forceinline__ bf16_t* x16() const { return (bf16_t*)(out + O_X) + (size_t)M * D; }
    __device__ __forceinline__ const float* xrow(int l, int row) const {
        if (l == 0) return row < NCTX ? inp(I_XP) + (size_t)row * D : inp(I_XS) + (size_t)(row - NCTX) * D;
        return out + O_X + (size_t)row * D;
    }
};

struct Unit { int pm, pn, aux; };
constexpr int BM = 256;
struct TileOrder {
    int nM, nN, nwg, G, c, rep;
    __device__ __forceinline__ void init(int nM_, int nN_, int G_, int c_, int rep_ = 1) { nM = nM_; nN = nN_; nwg = nM * nN; G = G_; c = c_; rep = rep_; }
    __device__ __forceinline__ bool next(int i, Unit& u) const {
        const int ti = i / rep; u.aux = i - ti * rep;
        const long L = (long)ti * G + c; if (L >= nwg) return false;
        int wgid = (int)L; { const int q = nwg / 8, r = nwg % 8, xcd = wgid % 8, off = wgid / 8; wgid = (xcd < r ? xcd * (q + 1) : r * (q + 1) + (xcd - r) * q) + off; }
        const int WGM = 8; const int nig = WGM * nN, gid = wgid / nig, fm = gid * WGM, gsz = (nM - fm) < WGM ? (nM - fm) : WGM;
        u.pm = fm + ((wgid % nig) % gsz); u.pn = (wgid % nig) / gsz; return true;
    }
};
template <int MF> struct ProbSimpleT {
    const bf16_t* A; const bf16_t* Bt; int K;
    __device__ __forceinline__ const bf16_t* a_tile(const Unit& u) const { return A + (size_t)u.pm * (64 * MF) * K; }
    __device__ __forceinline__ const bf16_t* b_tile(const Unit& u) const { return Bt + (size_t)u.pn * BM * K; }
};
typedef ProbSimpleT<4> ProbSimple;
template <int MF> struct ProbBranchT {
    const unsigned char* ws; int K;
    __device__ __forceinline__ const bf16_t* a_tile(const Unit& u) const { const size_t off = u.aux == 0 ? WS_OM : (u.aux == 1 ? WS_OA : WS_DQ); return (const bf16_t*)(ws + off) + (size_t)u.pm * (64 * MF) * K; }
    __device__ __forceinline__ const bf16_t* b_tile(const Unit& u) const { const size_t off = u.aux == 0 ? WS_WBM : (u.aux == 1 ? WS_WBA : WS_WBD); return (const bf16_t*)(ws + off) + (size_t)u.pn * BM * K; }
};
typedef f32x4 Acc[2][2][4][2];
typedef f32x4 AccH[2][4][2];

template <class Epi, class Prob, class Order>
__device__ __forceinline__ void gemm_ref(LAS unsigned char* lds, int tid_, const Prob& P, const Order& S, const Epi& E) {
    int tid = tid_; asm volatile("" : "+v"(tid));
    const int wid = tid >> 6, lane = tid & 63, wr = wid >> 2, wc = wid & 3, fr = lane & 15, fq = lane >> 4;
    LAS bf16_t* As = (LAS bf16_t*)lds; LAS bf16_t* Bs = As + 128 * 40;
    Unit u;
    for (int i = 0; S.next(i, u); ++i) {
        const bf16_t* Bg = P.b_tile(u); const int K = P.K;
#pragma unroll 1
        for (int ai = 0; ai < 2; ++ai) {
            const bf16_t* Ag = P.a_tile(u) + (size_t)ai * 128 * K;
            AccH acc;
#pragma unroll
            for (int b = 0; b < 2; ++b)
#pragma unroll
                for (int m = 0; m < 4; ++m)
#pragma unroll
                    for (int n = 0; n < 2; ++n) acc[b][m][n] = (f32x4){0.f, 0.f, 0.f, 0.f};
#pragma unroll 1
            for (int k0 = 0; k0 < K; k0 += 32) {
                __syncthreads();
                { const int r = tid >> 2, c8 = (tid & 3) * 8; *(LAS u32x4*)(As + r * 40 + c8) = *(const u32x4*)(Ag + (size_t)r * K + k0 + c8); }
#pragma unroll
                for (int j = 0; j < 2; ++j) { const int ch = tid + j * 512, r = ch >> 2, c8 = (ch & 3) * 8; *(LAS u32x4*)(Bs + r * 40 + c8) = *(const u32x4*)(Bg + (size_t)r * K + k0 + c8); }
                __syncthreads();
#pragma unroll 1
                for (int kk = 0; kk < 32; kk += 2) {
                    float a0[4], a1[4];
#pragma unroll
                    for (int m = 0; m < 4; ++m) { const unsigned w = *(const LAS unsigned*)(As + (wr * 64 + m * 16 + fr) * 40 + kk); a0[m] = lo_bf(w); a1[m] = hi_bf(w); }
#pragma unroll
                    for (int bj = 0; bj < 2; ++bj)
#pragma unroll
                        for (int n = 0; n < 2; ++n)
#pragma unroll
                            for (int e = 0; e < 4; ++e) { const unsigned w = *(const LAS unsigned*)(Bs + (bj * 128 + wc * 32 + fq * 8 + n * 4 + e) * 40 + kk);
                                const float b0 = lo_bf(w), b1 = hi_bf(w);
#pragma unroll
                                for (int m = 0; m < 4; ++m) acc[bj][m][n][e] += a0[m] * b0 + a1[m] * b1; }
                }
            }
            E(acc, ai, u, wr, wc, fr, fq);
        }
    }
    __syncthreads();
}

namespace pg8 {
constexpr int BK = 64, HALF = 128, HTB = HALF * BK * 2  , STAGE_BYTES = 8 * HTB;
__device__ __forceinline__ int lds_byte(int r, int c) { const int st = (r >> 4) * 2 + (c >> 5), rr = r & 15, cc = c & 31, ob = rr * 64 + cc * 2; return st * 1024 + (ob ^ (((ob >> 9) & 1) << 5)); }
__device__ __forceinline__ void stage_rc(int b, int& R, int& C) { const int st = b / 1024, sb = b % 1024, swz = sb ^ (((sb >> 9) & 1) << 5); R = (st >> 1) * 16 + swz / 64; C = (st & 1) * 32 + (swz % 64) / 2; }
__device__ __forceinline__ int perm32(int rho) { const int n = rho >> 4, i = rho & 15; return 8 * (i >> 2) + 4 * n + (i & 3); }

template <int MF, class Epi, class Prob, class Order>
__device__ __forceinline__ void gemm_phase(LAS unsigned char* lds, int tid_, const Prob& P, const Order& S, const Epi& E) {
    int tid = tid_; asm volatile("" : "+v"(tid));
    const int wid = __builtin_amdgcn_readfirstlane(tid >> 6), lane = tid & 63, wr = wid >> 2, wc = wid & 3, fr = lane & 15, fq = lane >> 4;
    const int K = P.K, nt = K / BK;
    unsigned voffA[2], voffB[2];
#pragma unroll
    for (int i = 0; i < 2; ++i) { int R, C; stage_rc(tid * 16 + i * 8192, R, C); const int Rb = (R & ~31) + perm32(R & 31);
        voffA[i] = (unsigned)(R * K + C) * 2u; voffB[i] = (unsigned)(Rb * K + C) * 2u; }
    const size_t kstep = (size_t)(BK * 2);
    const size_t hstepA = (size_t)(32 * MF) * K * 2, hstepB = (size_t)HALF * K * 2;
    const unsigned ldsw = (unsigned)wid * 1024u;
    const int aoff = lds_byte(wr * 16 * MF + fr, fq * 8), boff = lds_byte(wc * 32 + fr, fq * 8);
#define PG8_SA(b, h) (((b) * 2 + (h)) * HTB)
#define PG8_SB(b, h) ((4 + (b) * 2 + (h)) * HTB)
#define PG8_STAGE(bufoff, gbase, voff) do { _Pragma("unroll") for (int _i = 0; _i < 2; ++_i) \
        __builtin_amdgcn_global_load_lds((const unsigned*)((const char*)(gbase) + (voff)[_i]), (LAS unsigned*)(lds + (bufoff) + ldsw + _i * 8192), 16, 0, 0); } while (0)
#define PG8_LDA(dst, b, h) do { _Pragma("unroll") for (int m = 0; m < MF; ++m) _Pragma("unroll") for (int k = 0; k < 2; ++k) dst[m][k] = *(const LAS bf16x8*)(lds + PG8_SA(b, h) + aoff + m * 2048 + k * 1024); } while (0)
#define PG8_LDB(dst, b, h) do { _Pragma("unroll") for (int n = 0; n < 2; ++n) _Pragma("unroll") for (int k = 0; k < 2; ++k) dst[n][k] = *(const LAS bf16x8*)(lds + PG8_SB(b, h) + boff + n * 2048 + k * 1024); } while (0)
#define PG8_MMA(ai, bj, At, Bt) do { __builtin_amdgcn_s_setprio(1); _Pragma("unroll") for (int m = 0; m < MF; ++m) _Pragma("unroll") for (int n = 0; n < 2; ++n) _Pragma("unroll") for (int k = 0; k < 2; ++k) \
        acc[ai][bj][m][n] = __builtin_amdgcn_mfma_f32_16x16x32_bf16(Bt[n][k], At[m][k], acc[ai][bj][m][n], 0, 0, 0); __builtin_amdgcn_s_setprio(0); } while (0)
#define PG8_WAIT_V(n) asm volatile("s_waitcnt vmcnt(" #n ")" ::: "memory")
#define PG8_WAIT_L(n) asm volatile("s_waitcnt lgkmcnt(" #n ")" ::: "memory")
#define PG8_BAR __builtin_amdgcn_s_barrier()
#define PG8_SCHED __builtin_amdgcn_sched_barrier(0)
    Unit cur, nxt; int ui = 0;
    if (!S.next(0, cur)) return;
    Acc acc;
#pragma unroll
    for (int a = 0; a < 2; ++a)
#pragma unroll
        for (int b = 0; b < 2; ++b)
#pragma unroll
            for (int m = 0; m < 4; ++m)
#pragma unroll
                for (int n = 0; n < 2; ++n) acc[a][b][m][n] = (f32x4){0.f, 0.f, 0.f, 0.f};
    bf16x8 At[4][2], B0[2][2], B1[2][2];
    const char* cA = (const char*)P.a_tile(cur); const char* cB = (const char*)P.b_tile(cur);
    PG8_STAGE(PG8_SB(0, 0), cB, voffB); PG8_STAGE(PG8_SB(0, 1), cB + hstepB, voffB); PG8_STAGE(PG8_SA(0, 0), cA, voffA); PG8_STAGE(PG8_SA(0, 1), cA + hstepA, voffA);
    if (wr == 1) PG8_BAR;
    PG8_WAIT_V(2); PG8_BAR;
    PG8_STAGE(PG8_SB(1, 0), cB + kstep, voffB); PG8_STAGE(PG8_SA(1, 0), cA + kstep, voffA); PG8_STAGE(PG8_SB(1, 1), cB + hstepB + kstep, voffB);
    PG8_WAIT_V(6); PG8_BAR;
    for (;;) {
        const bool has_next = S.next(ui + 1, nxt);
        const char* nA = has_next ? (const char*)P.a_tile(nxt) : cA; const char* nB = has_next ? (const char*)P.b_tile(nxt) : cB;
        for (int t = 0; t < nt; t += 2) {
            const bool last = (t == nt - 2);
            const char* a1 = cA + (size_t)(t + 1) * kstep;
            const char* a2 = last ? nA : cA + (size_t)(t + 2) * kstep; const char* b2 = last ? nB : cB + (size_t)(t + 2) * kstep;
            const char* a3 = a2 + kstep; const char* b3 = b2 + kstep;
            PG8_LDB(B0, 0, 0); PG8_LDB(B1, 0, 1); PG8_SCHED; PG8_LDA(At, 0, 0); PG8_STAGE(PG8_SA(1, 1), a1 + hstepA, voffA);
            PG8_WAIT_V(8); PG8_WAIT_L(0); PG8_BAR; PG8_MMA(0, 0, At, B0); PG8_MMA(0, 1, At, B1); PG8_BAR; PG8_SCHED;
            PG8_LDA(At, 0, 1); PG8_STAGE(PG8_SB(0, 0), b2, voffB); PG8_STAGE(PG8_SB(0, 1), b2 + hstepB, voffB); PG8_STAGE(PG8_SA(0, 0), a2, voffA);
            PG8_WAIT_V(8); PG8_WAIT_L(0); PG8_BAR; PG8_MMA(1, 0, At, B0); PG8_MMA(1, 1, At, B1); PG8_BAR; PG8_SCHED;
            PG8_LDB(B0, 1, 0); PG8_LDB(B1, 1, 1); PG8_SCHED; PG8_LDA(At, 1, 0); PG8_STAGE(PG8_SA(0, 1), a2 + hstepA, voffA);
            PG8_WAIT_V(8); PG8_WAIT_L(0); PG8_BAR; PG8_MMA(0, 0, At, B0); PG8_MMA(0, 1, At, B1); PG8_BAR; PG8_SCHED;
            PG8_LDA(At, 1, 1); PG8_STAGE(PG8_SB(1, 0), b3, voffB); PG8_STAGE(PG8_SB(1, 1), b3 + hstepB, voffB); PG8_STAGE(PG8_SA(1, 0), a3, voffA);
            PG8_WAIT_V(8); PG8_WAIT_L(0); PG8_BAR; PG8_MMA(1, 0, At, B0); PG8_MMA(1, 1, At, B1); PG8_BAR; PG8_SCHED;
        }
        if (wr == 0) PG8_BAR;
        { int fr_ = fr, fq_ = fq; asm volatile("" : "+v"(fr_), "+v"(fq_));
          E(acc[0], 0, cur, wr, wc, fr_, fq_); E(acc[1], 1, cur, wr, wc, fr_, fq_); }
        if (!has_next) break;
#pragma unroll
        for (int a = 0; a < 2; ++a)
#pragma unroll
            for (int b = 0; b < 2; ++b)
#pragma unroll
                for (int m = 0; m < 4; ++m)
#pragma unroll
                    for (int n = 0; n < 2; ++n) acc[a][b][m][n] = (f32x4){0.f, 0.f, 0.f, 0.f};
        cur = nxt; cA = nA; cB = nB; ++ui;
        if (wr == 1) PG8_BAR;
    }
    PG8_WAIT_V(0);
    PG8_BAR;
#undef PG8_SA
#undef PG8_SB
#undef PG8_STAGE
#undef PG8_LDA
#undef PG8_LDB
#undef PG8_MMA
#undef PG8_WAIT_V
#undef PG8_WAIT_L
#undef PG8_BAR
#undef PG8_SCHED
}
}

__device__ __forceinline__ u32x4 pack8(const f32x4 v0, const f32x4 v1) { u32x4 w; w.x = pk2(v0[0], v0[1]); w.y = pk2(v0[2], v0[3]); w.z = pk2(v1[0], v1[1]); w.w = pk2(v1[2], v1[3]); return w; }
__device__ __forceinline__ void rope4(f32x4& v0, f32x4& v1, const float* tab) {
    const f32x4 t0 = *(const f32x4*)tab, t1 = *(const f32x4*)(tab + 4);
    const float a0 = v0[0] * t0[0] - v0[1] * t0[1], b0 = v0[0] * t0[1] + v0[1] * t0[0];
    const float a1 = v0[2] * t0[2] - v0[3] * t0[3], b1 = v0[2] * t0[3] + v0[3] * t0[2];
    const float a2 = v1[0] * t1[0] - v1[1] * t1[1], b2 = v1[0] * t1[1] + v1[1] * t1[0];
    const float a3 = v1[2] * t1[2] - v1[3] * t1[3], b3 = v1[2] * t1[3] + v1[3] * t1[2];
    v0 = (f32x4){a0, b0, a1, b1}; v1 = (f32x4){a2, b2, a3, b3};
}
__device__ __forceinline__ void rope4r(f32x4& v0, f32x4& v1, const f32x4 t0, const f32x4 t1) {
    const float a0 = v0[0] * t0[0] - v0[1] * t0[1], b0 = v0[0] * t0[1] + v0[1] * t0[0];
    const float a1 = v0[2] * t0[2] - v0[3] * t0[3], b1 = v0[2] * t0[3] + v0[3] * t0[2];
    const float a2 = v1[0] * t1[0] - v1[1] * t1[1], b2 = v1[0] * t1[1] + v1[1] * t1[0];
    const float a3 = v1[2] * t1[2] - v1[3] * t1[3], b3 = v1[2] * t1[3] + v1[3] * t1[2];
    v0 = (f32x4){a0, b0, a1, b1}; v1 = (f32x4){a2, b2, a3, b3};
}
template <int NPH> __device__ __forceinline__ const float* rope_tab(const float* T, int t, int i0) {
    const int pos = (i0 < NPH) ? (t >> 6) : (t & 63); return T + (pos * NPH + (i0 & (NPH - 1))) * 2;
}
#define EPI_LOOP_BEGIN \
    _Pragma("unroll") for (int m = 0; m < MF_; ++m) { const int row = u.pm * (64 * MF_) + ai * (32 * MF_) + wr * (16 * MF_) + m * 16 + fr; \
    _Pragma("unroll") for (int bj = 0; bj < 2; ++bj) { const int ct = bj * 128 + wc * 32 + 8 * fq; f32x4 v0 = acc[bj][m][0], v1 = acc[bj][m][1];
#define EPI_LOOP_END } asm volatile("" ::: "memory"); }

struct EpiZ {
    static constexpr int MF_ = 4;
    int l; unsigned char* ws; float* out; const float* gate_b;
    __device__ __forceinline__ void operator()(const AccH& acc, int ai, const Unit& u, int wr, int wc, int fr, int fq) const {
        const int pn = u.pn; const bool lat = u.pm >= NCTX / BM;
        bf16_t* const mqkvo = (bf16_t*)(ws + WS_MQKVO); bf16_t* const dq = (bf16_t*)(ws + WS_DQ); bf16_t* const dk = (bf16_t*)(ws + WS_DK); bf16_t* const dv = (bf16_t*)(ws + WS_DV);
        bf16_t* const acq = (bf16_t*)(ws + WS_ACQ); bf16_t* const ackv = (bf16_t*)(ws + WS_ACKV); bf16_t* const kr = (bf16_t*)(ws + WS_KV) + 1024; float* const mg = (float*)(ws + WS_MG);
        float* const ssq = (float*)(ws + WS_CTL) + CW_SSQ + l * M; float* const sskv = (float*)(ws + WS_CTL) + CW_SSKV + l * M;
        const float* const Td = (const float*)(ws + WS_SMALL) + SM_TD; const float* const Ta = (const float*)(ws + WS_SMALL) + SM_TA;
        f32x4 ta_[4][2], tb_[4][2];
        const bool rope_d = lat && pn >= 6 && pn < 10;
        if (rope_d) {
#pragma unroll
            for (int m = 0; m < 4; ++m)
#pragma unroll
                for (int bj = 0; bj < 2; ++bj) { const int row = u.pm * BM + ai * 128 + wr * 64 + m * 16 + fr, ct = bj * 128 + wc * 32 + 8 * fq;
                    const float* tp = rope_tab<16>(Td, (row - NCTX) & 4095, (ct & 63) >> 1); ta_[m][bj] = *(const f32x4*)tp; tb_[m][bj] = *(const f32x4*)(tp + 4); } }
        EPI_LOOP_BEGIN
            if (pn < 6) { *(u32x4*)(mqkvo + (size_t)row * 1536 + pn * 256 + ct) = pack8(v0, v1); }
            else if (pn < 8) {
                if (lat) rope4r(v0, v1, ta_[m][bj], tb_[m][bj]);
                *(u32x4*)(dq + (size_t)row * 512 + (pn - 6) * 256 + ct) = pack8(v0, v1);
            } else if (pn < 10) {
                const int c = (pn - 8) * 256 + ct;
                if (lat) rope4r(v0, v1, ta_[m][bj], tb_[m][bj]);
                else { float* o = out + O_DK + ((size_t)((row >> 8) * DEPTH + l) * CS + (row & 255)) * 512 + (c & ~63) + ((c & 63) >> 1);
                    *(f32x4*)o = (f32x4){v0[0], v0[2], v1[0], v1[2]}; *(f32x4*)(o + 32) = (f32x4){v0[1], v0[3], v1[1], v1[3]}; }
                *(u32x4*)(dk + (size_t)keyrow_of(row) * 512 + c) = pack8(v0, v1);
            } else if (pn < 12) {
                const int c = (pn - 10) * 256 + ct;
                if (!lat) { float* o = out + O_DV + ((size_t)((row >> 8) * DEPTH + l) * CS + (row & 255)) * 512 + c; *(f32x4*)o = v0; *(f32x4*)(o + 4) = v1; }
                *(u32x4*)(dv + (size_t)keyrow_of(row) * 512 + c) = pack8(v0, v1);
            } else if (pn == 12 || (pn == 13 && bj == 0) || pn == 14) {
                float s = (v0[0] * v0[0] + v0[1] * v0[1]) + (v0[2] * v0[2] + v0[3] * v0[3]) + (v1[0] * v1[0] + v1[1] * v1[1]) + (v1[2] * v1[2] + v1[3] * v1[3]);
                { const int ln_ = fq * 16 + fr; s += lane_xor(s, 16, ln_); s += lane_xor(s, 32, ln_); }
                if (pn == 14) { *(u32x4*)(ackv + (size_t)row * KVR + ct) = pack8(v0, v1); if (fq == 0) atomicAdd(sskv + row, s); }
                else { *(u32x4*)(acq + (size_t)row * QR + (pn - 12) * 256 + ct) = pack8(v0, v1); if (fq == 0) atomicAdd(ssq + row, s); }
            } else if (pn == 13) {
                if (ct < 160) {
                    const int c = ct - 128;
                    if (lat) rope4(v0, v1, rope_tab<8>(Ta, (row - NCTX) & 4095, c >> 1));
                    else { float* o = out + O_KROPE + ((size_t)((row >> 8) * DEPTH + l) * CS + (row & 255)) * ROPA + (c >> 1);
                        *(f32x4*)o = (f32x4){v0[0], v0[2], v1[0], v1[2]}; *(f32x4*)(o + 16) = (f32x4){v0[1], v0[3], v1[1], v1[3]}; }
                    *(u32x4*)(kr + (size_t)keyrow_of(row) * KVP + c) = pack8(v0, v1);
                } else if (ct < 176) {
                    const int c = ct - 160; const float* gb = gate_b + l * 16 + c; float* o = mg + (size_t)row * 16 + c;
                    *(f32x4*)o = v0 + *(const f32x4*)gb; *(f32x4*)(o + 4) = v1 + *(const f32x4*)(gb + 4);
                }
            }
        EPI_LOOP_END
    }
};
struct EpiQ {
    static constexpr int MF_ = 4;
    bf16_t* qa; const float* ssq; const float* Ta;
    __device__ __forceinline__ void operator()(const AccH& acc, int ai, const Unit& u, int wr, int wc, int fr, int fq) const {
        const bool lat = u.pm >= NCTX / BM;
        float rs_[4];
#pragma unroll
        for (int m = 0; m < 4; ++m) rs_[m] = ssq[u.pm * BM + ai * 128 + wr * 64 + m * 16 + fr];
        f32x4 ta_[4][2], tb_[4][2];
        if (lat) {
#pragma unroll
            for (int m = 0; m < 4; ++m)
#pragma unroll
                for (int bj = 0; bj < 2; ++bj) { const int row = u.pm * BM + ai * 128 + wr * 64 + m * 16 + fr, j = (u.pn * 256 + bj * 128 + wc * 32 + 8 * fq) % QKA;
                    const float* tp = rope_tab<8>(Ta, (row - NCTX) & 4095, (j >= NOPE ? j - NOPE : 0) >> 1); ta_[m][bj] = *(const f32x4*)tp; tb_[m][bj] = *(const f32x4*)(tp + 4); } }
        EPI_LOOP_BEGIN
            const int c = u.pn * 256 + ct; const float r = rsqrtf(rs_[m] * (1.f / QR) + EPS);
            v0 = v0 * r; v1 = v1 * r;
            const int j = c % QKA;
            if (lat && j >= NOPE) rope4r(v0, v1, ta_[m][bj], tb_[m][bj]);
            *(u32x4*)(qa + (size_t)row * 768 + c) = pack8(v0, v1);
        EPI_LOOP_END
    }
};
struct EpiKV {
    static constexpr int MF_ = 4;
    bf16_t* kv; const float* sskv; int cached;
    __device__ __forceinline__ void operator()(const AccH& acc, int ai, const Unit& u, int wr, int wc, int fr, int fq) const {
        float rs_[4] = {0.f, 0.f, 0.f, 0.f};
        if (!cached) {
#pragma unroll
            for (int m = 0; m < 4; ++m) rs_[m] = sskv[u.pm * BM + ai * 128 + wr * 64 + m * 16 + fr]; }
        EPI_LOOP_BEGIN
            const int c = u.pn * 256 + ct; float r = 1.f; int kr_;
            if (cached) { kr_ = NCTX + (row >> 8) * LT + (row & 255); }
            else { r = rsqrtf(rs_[m] * (1.f / KVR) + EPS); kr_ = keyrow_of(row); }
            v0 = v0 * r; v1 = v1 * r;
            *(u32x4*)(kv + (size_t)kr_ * KVP + c) = pack8(v0, v1);
        EPI_LOOP_END
    }
};
struct EpiGate {
    static constexpr int MF_ = 4;
    bf16_t* gates;
    __device__ __forceinline__ void operator()(const AccH& acc, int ai, const Unit& u, int wr, int wc, int fr, int fq) const {
        EPI_LOOP_BEGIN
#pragma unroll
            for (int e = 0; e < 4; ++e) { v0[e] = __builtin_amdgcn_rcpf(1.f + __builtin_amdgcn_exp2f(-1.4426950408889634f * v0[e])); v1[e] = __builtin_amdgcn_rcpf(1.f + __builtin_amdgcn_exp2f(-1.4426950408889634f * v1[e])); }
            *(u32x4*)(gates + (size_t)row * GN + u.pn * 256 + ct) = pack8(v0, v1);
        EPI_LOOP_END
    }
};
template <int MF> struct EpiBranchT {
    static constexpr int MF_ = MF;
    bf16_t* y; const bf16_t* gates;
    __device__ __forceinline__ void operator()(const AccH& acc, int ai, const Unit& u, int wr, int wc, int fr, int fq) const {
        if constexpr (MF == 3) {
            const int rb = u.pm * 192 + ai * 96 + wr * 48 + fr, cb = u.pn * 256 + wc * 32 + 8 * fq;
            u32x4 gw[3][2], yw[3][2];
#pragma unroll
            for (int m = 0; m < 3; ++m)
#pragma unroll
                for (int bj = 0; bj < 2; ++bj) { const size_t row = (size_t)(rb + m * 16); const int c = cb + bj * 128;
                    gw[m][bj] = *(const u32x4*)(gates + row * GN + u.aux * 1024 + c);
                    if (u.aux != 0) yw[m][bj] = *(const u32x4*)(y + row * D + c); else yw[m][bj] = (u32x4){0u, 0u, 0u, 0u}; }
#pragma unroll
            for (int m = 0; m < 3; ++m)
#pragma unroll
                for (int bj = 0; bj < 2; ++bj) { const size_t row = (size_t)(rb + m * 16); const int c = cb + bj * 128; const u32x4 g = gw[m][bj], o = yw[m][bj];
                    f32x4 p0 = (f32x4){lo_bf(o.x), hi_bf(o.x), lo_bf(o.y), hi_bf(o.y)}, p1 = (f32x4){lo_bf(o.z), hi_bf(o.z), lo_bf(o.w), hi_bf(o.w)};
                    p0 += acc[bj][m][0] * (f32x4){lo_bf(g.x), hi_bf(g.x), lo_bf(g.y), hi_bf(g.y)}; p1 += acc[bj][m][1] * (f32x4){lo_bf(g.z), hi_bf(g.z), lo_bf(g.w), hi_bf(g.w)};
                    *(u32x4*)(y + row * D + c) = pack8(p0, p1); }
            asm volatile("" ::: "memory");
            return;
        }
        EPI_LOOP_BEGIN
            const int c = u.pn * 256 + ct; const u32x4 g = *(const u32x4*)(gates + (size_t)row * GN + u.aux * 1024 + c);
            u32x4* yp = (u32x4*)(y + (size_t)row * D + c);
            f32x4 p0 = (f32x4){0.f, 0.f, 0.f, 0.f}, p1 = p0;
            if (u.aux != 0) { const u32x4 o = *yp; p0 = (f32x4){lo_bf(o.x), hi_bf(o.x), lo_bf(o.y), hi_bf(o.y)}; p1 = (f32x4){lo_bf(o.z), hi_bf(o.z), lo_bf(o.w), hi_bf(o.w)}; }
            p0 += v0 * (f32x4){lo_bf(g.x), hi_bf(g.x), lo_bf(g.y), hi_bf(g.y)}; p1 += v1 * (f32x4){lo_bf(g.z), hi_bf(g.z), lo_bf(g.w), hi_bf(g.w)};
            *yp = pack8(p0, p1);
        EPI_LOOP_END
    }
};
template <int MF> struct EpiResidT {
    static constexpr int MF_ = MF;
    const float* xp; const float* xs; int l0; const bf16_t* X16; bf16_t* Xo; const float* gmod;
    __device__ __forceinline__ void operator()(const AccH& acc, int ai, const Unit& u, int wr, int wc, int fr, int fq) const {
        if constexpr (MF == 3) { if (!l0) {
            const int rb = u.pm * 192 + ai * 96 + wr * 48 + fr, cb = u.pn * 256 + wc * 32 + 8 * fq;
            u32x4 xw[3][2]; f32x4 ga[3][2], gb[3][2];
#pragma unroll
            for (int m = 0; m < 3; ++m)
#pragma unroll
                for (int bj = 0; bj < 2; ++bj) { const int row = rb + m * 16, c = cb + bj * 128; const float* g = gmod + rg_of(row) * 6 * D + c;
                    xw[m][bj] = *(const u32x4*)(X16 + (size_t)row * D + c); ga[m][bj] = *(const f32x4*)g; gb[m][bj] = *(const f32x4*)(g + 4); }
#pragma unroll
            for (int m = 0; m < 3; ++m)
#pragma unroll
                for (int bj = 0; bj < 2; ++bj) { const int row = rb + m * 16, c = cb + bj * 128; const u32x4 w = xw[m][bj];
                    const f32x4 x0 = (f32x4){lo_bf(w.x), hi_bf(w.x), lo_bf(w.y), hi_bf(w.y)}, x1 = (f32x4){lo_bf(w.z), hi_bf(w.z), lo_bf(w.w), hi_bf(w.w)};
                    *(u32x4*)(Xo + (size_t)row * D + c) = pack8(x0 + ga[m][bj] * acc[bj][m][0], x1 + gb[m][bj] * acc[bj][m][1]); }
            asm volatile("" ::: "memory");
            return;
        } else {
            const int rb = u.pm * 192 + ai * 96 + wr * 48 + fr, cb = u.pn * 256 + wc * 32 + 8 * fq;
            f32x4 xa[3][2], xb[3][2], ga[3][2], gb[3][2];
#pragma unroll
            for (int m = 0; m < 3; ++m)
#pragma unroll
                for (int bj = 0; bj < 2; ++bj) { const int row = rb + m * 16, c = cb + bj * 128; const float* g = gmod + rg_of(row) * 6 * D + c;
                    const float* xi = (row < NCTX ? xp + (size_t)row * D : xs + (size_t)(row - NCTX) * D) + c;
                    xa[m][bj] = *(const f32x4*)xi; xb[m][bj] = *(const f32x4*)(xi + 4); ga[m][bj] = *(const f32x4*)g; gb[m][bj] = *(const f32x4*)(g + 4); }
#pragma unroll
            for (int m = 0; m < 3; ++m)
#pragma unroll
                for (int bj = 0; bj < 2; ++bj) { const int row = rb + m * 16, c = cb + bj * 128;
                    *(u32x4*)(Xo + (size_t)row * D + c) = pack8(xa[m][bj] + ga[m][bj] * acc[bj][m][0], xb[m][bj] + gb[m][bj] * acc[bj][m][1]); }
            asm volatile("" ::: "memory");
            return;
        } }
        EPI_LOOP_BEGIN
            const int c = u.pn * 256 + ct; const float* g = gmod + rg_of(row) * 6 * D + c;
            f32x4 x0, x1;
            if (l0) { const float* xi = row < NCTX ? xp + (size_t)row * D : xs + (size_t)(row - NCTX) * D; x0 = *(const f32x4*)(xi + c); x1 = *(const f32x4*)(xi + c + 4); }
            else { const u32x4 w = *(const u32x4*)(X16 + (size_t)row * D + c); x0 = (f32x4){lo_bf(w.x), hi_bf(w.x), lo_bf(w.y), hi_bf(w.y)}; x1 = (f32x4){lo_bf(w.z), hi_bf(w.z), lo_bf(w.w), hi_bf(w.w)}; }
            *(u32x4*)(Xo + (size_t)row * D + c) = pack8(x0 + *(const f32x4*)g * v0, x1 + *(const f32x4*)(g + 4) * v1);
        EPI_LOOP_END
    }
};
struct EpiRelu2 {
    static constexpr int MF_ = 4;
    bf16_t* U;
    __device__ __forceinline__ void operator()(const AccH& acc, int ai, const Unit& u, int wr, int wc, int fr, int fq) const {
        EPI_LOOP_BEGIN
#pragma unroll
            for (int e = 0; e < 4; ++e) { const float a = fmaxf(v0[e], 0.f), b = fmaxf(v1[e], 0.f); v0[e] = a * a; v1[e] = b * b; }
            *(u32x4*)(U + (size_t)row * DFF + u.pn * 256 + ct) = pack8(v0, v1);
        EPI_LOOP_END
    }
};

__device__ __forceinline__ int zcol_of(int n, float& cs) {
    cs = 1.f;
    if (n < 1536) { if (n < 256) cs = 0.125f; return n; }
    if (n < 1552) return 3328 + 160 + (n - 1536);
    if (n < 1936) return 3072 + (n - 1552);
    if (n < 2192) return 3584 + (n - 1936);
    if (n < 2224) { const int a = n - 2192; return 3328 + 128 + 2 * (a & 15) + (a >> 4); }
    if (n < 2736) { const int a = n - 2224, j = a & 63; return 1536 + (a & ~63) + 2 * (j & 31) + (j >> 5); }
    if (n < 3248) { const int a = n - 2736, j = a & 63; return 2048 + (a & ~63) + 2 * (j & 31) + (j >> 5); }
    if (n < 3760) return 2560 + (n - 3248);
    return ZN + (n - 3760);
}
__device__ __forceinline__ int qcol_of(int n) { const int h = n / QKA, j = n - h * QKA; if (j < NOPE) return n; const int a = j - NOPE; return h * QKA + NOPE + 2 * (a & 15) + (a >> 4); }
template <int MODE>
__device__ __forceinline__ void transpose_item(const float* W, int K, int N, bf16_t* WT, const float* kscale, LAS float* scr, int item, int lane) {
    const int nblk = (N + 31) / 32, kb = item / nblk, nb = item - kb * nblk, k0 = 64 * kb, n0 = 32 * nb;
    const int nl = n0 + (lane & 31); const bool nok = nl < N;
    float tmp[32];
#pragma unroll
    for (int i = 0; i < 32; ++i) { const int kk = 2 * i + (lane >> 5); tmp[i] = nok ? W[(size_t)(k0 + kk) * N + nl] : 0.f; }
#pragma unroll
    for (int i = 0; i < 32; ++i) { const int kk = 2 * i + (lane >> 5); scr[kk * 33 + (lane & 31)] = tmp[i]; }
    asm volatile("s_waitcnt lgkmcnt(0)" ::: "memory");
    const int c = lane & 7;
    float ks[8];
#pragma unroll
    for (int e = 0; e < 8; ++e) ks[e] = kscale ? kscale[k0 + 8 * c + e] : 1.f;
#pragma unroll
    for (int j = 0; j < 4; ++j) { const int n = (lane >> 3) + 8 * j; const LAS float* s = scr + (8 * c) * 33 + n;
        if (n0 + n < N) { float cs = 1.f; int dr;
            if (MODE == 1) dr = zcol_of(n0 + n, cs); else if (MODE == 2) dr = qcol_of(n0 + n); else dr = n0 + n;
            u32x4 o; o.x = pk2(s[0 * 33] * ks[0] * cs, s[1 * 33] * ks[1] * cs); o.y = pk2(s[2 * 33] * ks[2] * cs, s[3 * 33] * ks[3] * cs);
            o.z = pk2(s[4 * 33] * ks[4] * cs, s[5 * 33] * ks[5] * cs); o.w = pk2(s[6 * 33] * ks[6] * cs, s[7 * 33] * ks[7] * cs);
            *(u32x4*)(WT + (size_t)dr * K + k0 + 8 * c) = o; } }
    asm volatile("s_waitcnt lgkmcnt(0)" ::: "memory");
}
__device__ __forceinline__ void rmsmod_row(const float* xrow, const float* g, const float* sc, const float* sh, bf16_t* orow, int lane) {
    f32x4 v[4]; float s = 0.f;
#pragma unroll
    for (int j = 0; j < 4; ++j) { v[j] = *(const f32x4*)(xrow + 4 * lane + 256 * j); s += (v[j][0] * v[j][0] + v[j][1] * v[j][1]) + (v[j][2] * v[j][2] + v[j][3] * v[j][3]); }
    const float r = rsqrtf(wave_sum(s, lane) * (1.f / D) + EPS);
#pragma unroll
    for (int j = 0; j < 4; ++j) { const int c = 4 * lane + 256 * j; const f32x4 gg = *(const f32x4*)(g + c), a = *(const f32x4*)(sc + c), b = *(const f32x4*)(sh + c);
        const f32x4 h = v[j] * r * gg * (a + 1.f) + b; u32x2 w; w.x = pk2(h[0], h[1]); w.y = pk2(h[2], h[3]); *(u32x2*)(orow + c) = w; }
}

__device__ __forceinline__ void rmsmod_row16(const bf16_t* xrow, const float* g, const float* sc, const float* sh, bf16_t* orow, int lane) {
    f32x4 v[4]; float s = 0.f;
#pragma unroll
    for (int j = 0; j < 4; ++j) { const u32x2 w = *(const u32x2*)(xrow + 4 * lane + 256 * j); v[j] = (f32x4){lo_bf(w.x), hi_bf(w.x), lo_bf(w.y), hi_bf(w.y)}; s += (v[j][0] * v[j][0] + v[j][1] * v[j][1]) + (v[j][2] * v[j][2] + v[j][3] * v[j][3]); }
    const float r = rsqrtf(wave_sum(s, lane) * (1.f / D) + EPS);
#pragma unroll
    for (int j = 0; j < 4; ++j) { const int c = 4 * lane + 256 * j; const f32x4 gg = *(const f32x4*)(g + c), a = *(const f32x4*)(sc + c), b = *(const f32x4*)(sh + c);
        const f32x4 h = v[j] * r * gg * (a + 1.f) + b; u32x2 w; w.x = pk2(h[0], h[1]); w.y = pk2(h[2], h[3]); *(u32x2*)(orow + c) = w; }
}

template <bool F32IN, int NB>
__device__ __forceinline__ void rmsmod_rows(Frame& F, int l, int row0, int stride, const float* g, int ch_sc, int ch_sh) {
    const int lane = F.lane; bf16_t* H = F.wsp<bf16_t>(WS_H);
    f32x4 v[NB][4], a[NB][4], b[NB][4], gg[4];
#pragma unroll
    for (int i = 0; i < NB; ++i) { const int row = min(row0 + i * stride, M - 1), rg = rg_of(row);
        if constexpr (F32IN) { const float* x = F.xrow(0, row);
#pragma unroll
            for (int j = 0; j < 4; ++j) v[i][j] = *(const f32x4*)(x + 4 * lane + 256 * j); }
        else { const bf16_t* x = F.x16() + (size_t)row * D;
#pragma unroll
            for (int j = 0; j < 4; ++j) { const u32x2 w = *(const u32x2*)(x + 4 * lane + 256 * j); v[i][j] = (f32x4){lo_bf(w.x), hi_bf(w.x), lo_bf(w.y), hi_bf(w.y)}; } }
        const float* sc = F.mod(l, rg, ch_sc); const float* sh = F.mod(l, rg, ch_sh);
#pragma unroll
        for (int j = 0; j < 4; ++j) { a[i][j] = *(const f32x4*)(sc + 4 * lane + 256 * j); b[i][j] = *(const f32x4*)(sh + 4 * lane + 256 * j); } }
#pragma unroll
    for (int j = 0; j < 4; ++j) gg[j] = *(const f32x4*)(g + 4 * lane + 256 * j);
#pragma unroll
    for (int i = 0; i < NB; ++i) { const int row = row0 + i * stride; float s = 0.f;
#pragma unroll
        for (int j = 0; j < 4; ++j) s += (v[i][j][0] * v[i][j][0] + v[i][j][1] * v[i][j][1]) + (v[i][j][2] * v[i][j][2] + v[i][j][3] * v[i][j][3]);
        const float r = rsqrtf(wave_sum(s, lane) * (1.f / D) + EPS);
        if (row < M) {
#pragma unroll
            for (int j = 0; j < 4; ++j) { const f32x4 h = v[i][j] * r * gg[j] * (a[i][j] + 1.f) + b[i][j]; u32x2 w; w.x = pk2(h[0], h[1]); w.y = pk2(h[2], h[3]); *(u32x2*)(H + (size_t)row * D + 4 * lane + 256 * j) = w; } } }
}

__device__ __forceinline__ void phase_mod(Frame& F) {
    LAS float* sl = (LAS float*)F.lds;
    for (int i = F.tid; i < 3 * D; i += NTHR) { const int r = i / D, k = i - r * D; const float cv = r == 0 ? F.inp(I_CCTX)[k] : F.inp(I_C)[(r - 1) * D + k]; sl[i] = cv * sigmoidf_(cv); }
    __syncthreads();
    LAS float* red = sl + 3 * D;
    for (int item = F.bid; item < DEPTH * 96; item += F.G) {
        const int l = item / 96, n0 = (item % 96) * 64; const float* W = F.inp(I_WMOD) + (size_t)l * D * 6 * D + n0 + F.lane;
        float a0 = 0.f, a1 = 0.f, a2 = 0.f;
#pragma unroll 8
        for (int kk = 0; kk < 128; ++kk) { const int k = F.wave * 128 + kk; const float w = W[(size_t)k * 6 * D]; a0 += sl[k] * w; a1 += sl[D + k] * w; a2 += sl[2 * D + k] * w; }
        red[(F.wave * 3 + 0) * 64 + F.lane] = a0; red[(F.wave * 3 + 1) * 64 + F.lane] = a1; red[(F.wave * 3 + 2) * 64 + F.lane] = a2;
        __syncthreads();
        if (F.tid < 192) { const int r = F.tid >> 6, c = F.tid & 63; float s = 0.f;
#pragma unroll
            for (int w = 0; w < 8; ++w) s += red[(w * 3 + r) * 64 + c];
            const int n = n0 + c; F.smallf()[SM_MOD + (l * 3 + r) * 6 * D + n] = s + F.inp(I_BMOD)[l * 6 * D + n]; }
        __syncthreads();
    }
    if (F.bid == F.G - 1) {
        for (int i = F.tid; i < 64 * 16; i += NTHR) { const int p = i >> 4, j = i & 15; double inv = 1.0; for (int q = 0; q < j; ++q) inv *= 0.56234132519034908;
            float s, c; sincosf((float)((double)p * inv), &s, &c); F.smallf()[SM_TD + i * 2] = c; F.smallf()[SM_TD + i * 2 + 1] = s; }
        for (int i = F.tid; i < 64 * 8; i += NTHR) { const int p = i >> 3, j = i & 7; double inv = 1.0; for (int q = 0; q < j; ++q) inv *= 0.31622776601683794;
            float s, c; sincosf((float)((double)p * inv), &s, &c); F.smallf()[SM_TA + i * 2] = c; F.smallf()[SM_TA + i * 2 + 1] = s; }
        if (F.wave < DEPTH) { const int l = F.wave; const float* lv = F.inp(I_LAMBDA) + l * 4 * DKD;
            const float s1 = wave_sum(lv[F.lane] * lv[64 + F.lane], F.lane), s2 = wave_sum(lv[128 + F.lane] * lv[192 + F.lane], F.lane);
            const float li = 0.8f - 0.6f * expf(-0.3f * (float)l);
            if (F.lane == 0) { F.smallf()[SM_LAM + l * 2] = expf(s1) - expf(s2) + li; F.smallf()[SM_LAM + l * 2 + 1] = li; } }
    }
}

template <int SET>
__device__ __forceinline__ void convert_set(Frame& F, int l, int gw, int NGW) {
    LAS float* scr = (LAS float*)(F.lds + F.wave * 16384);
    constexpr int I_IN = (D / 64) * ((INC + 31) / 32), I_Q = (QR / 64) * (768 / 32), I_KV = (KVR / 64) * (1024 / 32), I_BR = (512 / 64) * (D / 32),
                  I_OUT = (D / 64) * (D / 32), I_F1 = (D / 64) * (DFF / 32), I_F2 = (DFF / 64) * (D / 32);
    if (SET == 0) {
        constexpr int NITEMS = I_IN + I_Q + 2 * I_KV;
        for (int it = gw; it < NITEMS; it += NGW) {
            int r = it;
            if (r < I_IN) { transpose_item<1>(F.inp(I_WIN) + (size_t)l * D * INC, D, INC, F.wsp<bf16_t>(WS_WIN), nullptr, scr, r, F.lane); continue; } r -= I_IN;
            if (r < I_Q) { transpose_item<2>(F.inp(I_WQUP) + (size_t)l * QR * 768, QR, 768, F.wsp<bf16_t>(WS_WQ), F.inp(I_QNG) + l * QR, scr, r, F.lane); continue; } r -= I_Q;
            if (r < I_KV) { transpose_item<0>(F.inp(I_WKVUP) + (size_t)l * KVR * 1024, KVR, 1024, F.wsp<bf16_t>(WS_WKVG), F.inp(I_KVNG) + l * KVR, scr, r, F.lane); continue; } r -= I_KV;
            transpose_item<0>(F.inp(I_WKVUP) + (size_t)l * KVR * 1024, KVR, 1024, F.wsp<bf16_t>(WS_WKV), nullptr, scr, r, F.lane);
        }
    } else if (SET == 1) {
        constexpr int NITEMS = 3 * I_BR + I_OUT;
        for (int it = gw; it < NITEMS; it += NGW) {
            int r = it;
            if (r < I_BR) { transpose_item<0>(F.inp(I_WBM) + (size_t)l * 512 * D, 512, D, F.wsp<bf16_t>(WS_WBM), nullptr, scr, r, F.lane); continue; } r -= I_BR;
            if (r < I_BR) { transpose_item<0>(F.inp(I_WBA) + (size_t)l * 512 * D, 512, D, F.wsp<bf16_t>(WS_WBA), nullptr, scr, r, F.lane); continue; } r -= I_BR;
            if (r < I_BR) { transpose_item<0>(F.inp(I_WBD) + (size_t)l * 512 * D, 512, D, F.wsp<bf16_t>(WS_WBD), nullptr, scr, r, F.lane); continue; } r -= I_BR;
            transpose_item<0>(F.inp(I_WOUT) + (size_t)l * D * D, D, D, F.wsp<bf16_t>(WS_WOUT), nullptr, scr, r, F.lane);
        }
    } else if (SET == 2) {
        for (int it = gw; it < I_F1; it += NGW) transpose_item<0>(F.inp(I_WFF1) + (size_t)l * D * DFF, D, DFF, F.wsp<bf16_t>(WS_W1), nullptr, scr, it, F.lane);
    } else {
        for (int it = gw; it < I_F2; it += NGW) transpose_item<0>(F.inp(I_WFF2) + (size_t)l * DFF * D, DFF, D, F.wsp<bf16_t>(WS_W2), nullptr, scr, it, F.lane);
    }
}
template <int SET>
__device__ __forceinline__ void convert_on_idle(Frame& F, int l, int nwg) {
    const int r = nwg % F.G, nw = r == 0 ? F.G : F.G - r, wi = r == 0 ? F.bid : F.bid - r;
    if (wi >= 0) convert_set<SET>(F, l, wi * NWAVES + F.wave, nw * NWAVES);
}
constexpr int LATE_ITEMS = 3 * (512 / 64) * (D / 32) + (D / 64) * (D / 32) + (D / 64) * (DFF / 32) + (DFF / 64) * (D / 32), CONV_CHUNKS = LATE_ITEMS / 64;
static_assert(LATE_ITEMS % 64 == 0, "late conversion chunks");
__device__ __forceinline__ void convert_late_chunk(Frame& F, int l, int chunk) {
    LAS float* scr = (LAS float*)(F.lds + F.wave * 16384);
    constexpr int I_BR = (512 / 64) * (D / 32), I_OUT = (D / 64) * (D / 32), I_F1 = (D / 64) * (DFF / 32);
#pragma unroll 1
    for (int k = 0; k < 8; ++k) { int r = chunk * 64 + F.wave * 8 + k;
        if (r < I_BR) { transpose_item<0>(F.inp(I_WBM) + (size_t)l * 512 * D, 512, D, F.wsp<bf16_t>(WS_WBM), nullptr, scr, r, F.lane); continue; } r -= I_BR;
        if (r < I_BR) { transpose_item<0>(F.inp(I_WBA) + (size_t)l * 512 * D, 512, D, F.wsp<bf16_t>(WS_WBA), nullptr, scr, r, F.lane); continue; } r -= I_BR;
        if (r < I_BR) { transpose_item<0>(F.inp(I_WBD) + (size_t)l * 512 * D, 512, D, F.wsp<bf16_t>(WS_WBD), nullptr, scr, r, F.lane); continue; } r -= I_BR;
        if (r < I_OUT) { transpose_item<0>(F.inp(I_WOUT) + (size_t)l * D * D, D, D, F.wsp<bf16_t>(WS_WOUT), nullptr, scr, r, F.lane); continue; } r -= I_OUT;
        if (r < I_F1) { transpose_item<0>(F.inp(I_WFF1) + (size_t)l * D * DFF, D, DFF, F.wsp<bf16_t>(WS_W1), nullptr, scr, r, F.lane); continue; } r -= I_F1;
        transpose_item<0>(F.inp(I_WFF2) + (size_t)l * DFF * D, DFF, D, F.wsp<bf16_t>(WS_W2), nullptr, scr, r, F.lane); }
    __syncthreads();
}
__device__ __forceinline__ void phase_layer_prep(Frame& F, int l) {
    const int gw = F.bid * NWAVES + F.wave, NGW = F.G * NWAVES;
    const int gt = F.bid * NTHR + F.tid, NGT = F.G * NTHR;
    for (int i = gt; i < LB * PAST * KVR; i += NGT) { const int b = i / (PAST * KVR), r = i - b * PAST * KVR;
        F.wsp<bf16_t>(WS_CKVC)[i] = (bf16_t)f2bf(F.inp(I_CCKV)[((size_t)(b * DEPTH + l) * PAST) * KVR + r]); }
    for (int i = gt; i < LB * PAST * ROPA; i += NGT) { const int b = i / (PAST * ROPA), r = i - b * PAST * ROPA, t = r / ROPA, a = r % ROPA;
        F.wsp<bf16_t>(WS_KV)[(size_t)(NCTX + b * LT + t) * KVP + 1024 + 2 * (a & 15) + (a >> 4)] = (bf16_t)f2bf(F.inp(I_CKR)[((size_t)(b * DEPTH + l) * PAST + t) * ROPA + a]); }
    for (int i = gt; i < LB * PAST * 512; i += NGT) { const int b = i / (PAST * 512), r = i - b * PAST * 512, t = r >> 9, c = r & 511, j = c & 63;
        const size_t src = ((size_t)(b * DEPTH + l) * PAST + t) * 512 + c; const size_t kr_ = (size_t)(NCTX + b * LT + t) * 512;
        F.wsp<bf16_t>(WS_DK)[kr_ + (c & ~63) + 2 * (j & 31) + (j >> 5)] = (bf16_t)f2bf(F.inp(I_CDK)[src]);
        F.wsp<bf16_t>(WS_DV)[kr_ + c] = (bf16_t)f2bf(F.inp(I_CDV)[src]); }
    if (l == 0) { for (int row = gw; row < M; row += NGW * 2) rmsmod_rows<true, 2>(F, l, row, NGW, F.inp(I_N1G) + l * D, 1, 0); }
    else { for (int row = gw; row < M; row += NGW * 3) rmsmod_rows<false, 3>(F, l, row, NGW, F.inp(I_N1G) + l * D, 1, 0); }
}

__device__ __forceinline__ void phase_ckv_out(Frame& F, int l) {
    const int gt = F.bid * NTHR + F.tid, NGT = F.G * NTHR; const float* ss = (const float*)(F.ws + WS_CTL) + CW_SSKV + l * M;
    for (int i = gt; i < NCTX * KVR / 8; i += NGT) { const int row = i >> 5, c = (i & 31) * 8; const float r = rsqrtf(ss[row] * (1.f / KVR) + EPS);
        const u32x4 w = *(const u32x4*)(F.wsp<bf16_t>(WS_ACKV) + (size_t)row * KVR + c); const float* g = F.inp(I_KVNG) + l * KVR + c;
        float* o = F.out + O_CKV + ((size_t)((row >> 8) * DEPTH + l) * CS + (row & 255)) * KVR + c;
        *(f32x4*)o = (f32x4){lo_bf(w.x), hi_bf(w.x), lo_bf(w.y), hi_bf(w.y)} * r * *(const f32x4*)g;
        *(f32x4*)(o + 4) = (f32x4){lo_bf(w.z), hi_bf(w.z), lo_bf(w.w), hi_bf(w.w)} * r * *(const f32x4*)(g + 4); }
}

#define UNPACK8(dst, off, vv) do { dst[(off)] = lo_bf((vv)[0]); dst[(off) + 1] = hi_bf((vv)[0]); dst[(off) + 2] = lo_bf((vv)[1]); dst[(off) + 3] = hi_bf((vv)[1]); \
    dst[(off) + 4] = lo_bf((vv)[2]); dst[(off) + 5] = hi_bf((vv)[2]); dst[(off) + 6] = lo_bf((vv)[3]); dst[(off) + 7] = hi_bf((vv)[3]); } while (0)
__device__ __forceinline__ void mlstm_ref(Frame& F, int l) {
    LAS float* qs = (LAS float*)F.lds;
    LAS float* ks = qs + 64 * 65;
    LAS float* vs = ks + 64 * 65;
    LAS float* As = vs + 64 * 128;
    LAS float* Cs = As + 64 * 65;
    LAS float* ns = Cs + 64 * 128;
    LAS float* gs = ns + 64;
    LAS float* Ms = gs + 64;
    LAS float* bs = Ms + 64;
    LAS float* sc = bs + 64;
    const bf16_t* MQ = F.wsp<bf16_t>(WS_MQKVO); const float* MG = F.wsp<float>(WS_MG);
    const int tid = F.tid;
    for (int st = F.bid; st < (CB + LB) * 2 * HM; st += F.G) {
        const int head = st & 3, dir = (st >> 2) & 1, pb = st >> 3; const bool lat = pb >= CB;
        const int b = lat ? pb - CB : pb; const int N = lat ? LS : CS; const int row0 = lat ? NCTX + b * LS : b * CS; const int nc = N / 64;
        for (int i = tid; i < 64 * 128; i += NTHR) Cs[i] = lat ? F.inp(I_SC)[(((size_t)(b * DEPTH + l) * 2 + dir) * HM + head) * 64 * 128 + i] : 0.f;
        if (tid < 64) ns[tid] = lat ? F.inp(I_SN)[(((size_t)(b * DEPTH + l) * 2 + dir) * HM + head) * 64 + tid] : 0.f;
        if (tid == 0) sc[0] = lat ? F.inp(I_SM)[((size_t)(b * DEPTH + l) * 2 + dir) * HM + head] : 0.f;
        __syncthreads();
        for (int c = 0; c < nc; ++c) {
            for (int i = tid; i < 64 * 64; i += NTHR) { const int r = i >> 6, d = i & 63; const int tau = c * 64 + r, t = dir ? N - 1 - tau : tau; const size_t rb = (size_t)(row0 + t) * 1536;
                qs[r * 65 + d] = bf2f(MQ[rb + head * 64 + d]); ks[r * 65 + d] = bf2f(MQ[rb + 256 + head * 64 + d]); }
            for (int i = tid; i < 64 * 128; i += NTHR) { const int r = i >> 7, e = i & 127; const int tau = c * 64 + r, t = dir ? N - 1 - tau : tau;
                vs[r * 128 + e] = bf2f(MQ[(size_t)(row0 + t) * 1536 + 512 + head * 128 + e]); }
            if (tid < 64) { const int tau = c * 64 + tid, t = dir ? N - 1 - tau : tau; const float* g = MG + (size_t)(row0 + t) * 16;
                gs[tid] = g[dir * 4 + head]; bs[tid] = logsigmoidf_(g[8 + dir * 4 + head]); }
            __syncthreads();
            if (tid == 0) { float bb = 0.f, pm = -1e30f; const float m = sc[0];
                for (int i = 0; i < 64; ++i) { bb += bs[i]; bs[i] = bb; const float g = gs[i] - bb; gs[i] = g; pm = fmaxf(pm, g); Ms[i] = fmaxf(m, pm); } }
            __syncthreads();
            const float m = sc[0];
            for (int i = tid; i < 64 * 64; i += NTHR) { const int r = i >> 6, s = i & 63; float a = 0.f;
                if (s <= r) { float dt = 0.f;
#pragma unroll 8
                    for (int d = 0; d < 64; ++d) dt += qs[r * 65 + d] * ks[s * 65 + d];
                    a = expf(gs[s] - Ms[r]) * dt; }
                As[r * 65 + s] = a; }
            __syncthreads();
            if (tid < 64) { const int r = tid; float dn = 0.f, da = 0.f;
                for (int d = 0; d < 64; ++d) dn += qs[r * 65 + d] * ns[d];
                for (int s = 0; s < 64; ++s) da += As[r * 65 + s];
                const float den = expf(m - Ms[r]) * dn + da; const int tau = c * 64 + r, t = dir ? N - 1 - tau : tau;
                F.wsp<float>(WS_DEN)[(size_t)(row0 + t) * 8 + dir * 4 + head] = fmaxf(fabsf(den), expf(-(bs[r] + Ms[r]))); }
            for (int i = tid; i < 64 * 128; i += NTHR) { const int r = i >> 7, e = i & 127; float x = 0.f, y = 0.f;
#pragma unroll 8
                for (int d = 0; d < 64; ++d) x += qs[r * 65 + d] * Cs[d * 128 + e];
#pragma unroll 8
                for (int s = 0; s < 64; ++s) y += As[r * 65 + s] * vs[s * 128 + e];
                const int tau = c * 64 + r, t = dir ? N - 1 - tau : tau;
                F.wsp<bf16_t>(dir ? WS_HB : WS_HF)[(size_t)(row0 + t) * 512 + head * 128 + e] = (bf16_t)f2bf(expf(m - Ms[r]) * x + y); }
            __syncthreads();
            const float M63 = Ms[63], wold = expf(m - M63);
            for (int i = tid; i < 64 * 128; i += NTHR) { const int d = i >> 7, e = i & 127; float x = 0.f;
#pragma unroll 8
                for (int s = 0; s < 64; ++s) x += expf(gs[s] - M63) * ks[s * 65 + d] * vs[s * 128 + e];
                Cs[i] = wold * Cs[i] + x; }
            if (tid < 64) { float x = 0.f; for (int s = 0; s < 64; ++s) x += expf(gs[s] - M63) * ks[s * 65 + tid]; ns[tid] = wold * ns[tid] + x; }
            __syncthreads();
            if (tid == 0) sc[0] = bs[63] + M63;
            __syncthreads();
        }
        if (!lat) {
            const size_t sb = ((size_t)(b * DEPTH + l) * 2 + dir) * HM + head;
            for (int i = tid; i < 64 * 128; i += NTHR) F.out[O_C + sb * 64 * 128 + i] = Cs[i];
            if (tid < 64) F.out[O_N + sb * 64 + tid] = ns[tid];
            if (tid == 0) F.out[O_M + sb] = sc[0];
        }
        __syncthreads();
    }
}

namespace fa {
typedef float f32x16 __attribute__((ext_vector_type(16)));
typedef short s16x4 __attribute__((ext_vector_type(4)));
#define SBAR() __builtin_amdgcn_sched_barrier(0)
__device__ __forceinline__ int crow(int r, int hi) { return (r & 3) + 8 * (r >> 2) + 4 * hi; }
__device__ __forceinline__ unsigned cvtpk(float lo, float hi) { unsigned r; asm volatile("v_cvt_pk_bf16_f32 %0, %1, %2" : "=v"(r) : "v"(lo), "v"(hi)); return r; }
constexpr float THR = 8.f;
template <int NCB> __device__ __forceinline__ int v_st(int k, int c) { const int kk = (k & ~0xC) | ((k & 4) << 1) | ((k & 8) >> 1); return ((kk >> 3) * NCB + (c >> 5)) * 512 + ((kk & 7) * 32 + (c & 31)) * 2; }
__device__ __forceinline__ int v_rd_base(int lane) { return ((lane & 3) << 3) | (((lane >> 2) & 3) << 6) | (((lane >> 4) & 1) << 5) | (((lane >> 5) & 1) << 8); }
template <int NCB> constexpr int v_rd_off(int d0, int ks, int half) { return d0 * 512 + ks * NCB * 1024 + half * NCB * 512; }
template <int OFF> __device__ __forceinline__ s16x4 tr_read(int vb) { s16x4 r; asm volatile("ds_read_b64_tr_b16 %0, %1 offset:%2" : "=&v"(r) : "v"(vb), "i"(OFF) : "memory"); return r; }
template <int NCB, int D0, int BO> __device__ __forceinline__ void pv_one(f32x16& od, int vb, bf16x8 pa0, bf16x8 pa1, bf16x8 pa2, bf16x8 pa3) {
    const s16x4 l0 = tr_read<BO + v_rd_off<NCB>(D0, 0, 0)>(vb), h0 = tr_read<BO + v_rd_off<NCB>(D0, 0, 1)>(vb), l1 = tr_read<BO + v_rd_off<NCB>(D0, 1, 0)>(vb), h1 = tr_read<BO + v_rd_off<NCB>(D0, 1, 1)>(vb);
    const s16x4 l2 = tr_read<BO + v_rd_off<NCB>(D0, 2, 0)>(vb), h2 = tr_read<BO + v_rd_off<NCB>(D0, 2, 1)>(vb), l3 = tr_read<BO + v_rd_off<NCB>(D0, 3, 0)>(vb), h3 = tr_read<BO + v_rd_off<NCB>(D0, 3, 1)>(vb);
    asm volatile("s_waitcnt lgkmcnt(0)" ::: "memory"); SBAR();
#define PK(L, H) (bf16x8){L[0], L[1], L[2], L[3], H[0], H[1], H[2], H[3]}
    od = __builtin_amdgcn_mfma_f32_32x32x16_bf16(pa0, PK(l0, h0), od, 0, 0, 0);
    od = __builtin_amdgcn_mfma_f32_32x32x16_bf16(pa1, PK(l1, h1), od, 0, 0, 0);
    od = __builtin_amdgcn_mfma_f32_32x32x16_bf16(pa2, PK(l2, h2), od, 0, 0, 0);
    od = __builtin_amdgcn_mfma_f32_32x32x16_bf16(pa3, PK(l3, h3), od, 0, 0, 0);
#undef PK
}
template <int NCB, int D0, int BO> __device__ __forceinline__ void pv_two(f32x16& oa, f32x16& ob, int vb, bf16x8 pa0, bf16x8 pa1, bf16x8 pa2, bf16x8 pa3) {
    const s16x4 l0 = tr_read<BO + v_rd_off<NCB>(D0, 0, 0)>(vb), h0 = tr_read<BO + v_rd_off<NCB>(D0, 0, 1)>(vb), m0 = tr_read<BO + v_rd_off<NCB>(D0 + 1, 0, 0)>(vb), n0 = tr_read<BO + v_rd_off<NCB>(D0 + 1, 0, 1)>(vb);
    const s16x4 l1 = tr_read<BO + v_rd_off<NCB>(D0, 1, 0)>(vb), h1 = tr_read<BO + v_rd_off<NCB>(D0, 1, 1)>(vb), m1 = tr_read<BO + v_rd_off<NCB>(D0 + 1, 1, 0)>(vb), n1 = tr_read<BO + v_rd_off<NCB>(D0 + 1, 1, 1)>(vb);
    const s16x4 l2 = tr_read<BO + v_rd_off<NCB>(D0, 2, 0)>(vb), h2 = tr_read<BO + v_rd_off<NCB>(D0, 2, 1)>(vb), m2 = tr_read<BO + v_rd_off<NCB>(D0 + 1, 2, 0)>(vb), n2 = tr_read<BO + v_rd_off<NCB>(D0 + 1, 2, 1)>(vb);
    const s16x4 l3 = tr_read<BO + v_rd_off<NCB>(D0, 3, 0)>(vb), h3 = tr_read<BO + v_rd_off<NCB>(D0, 3, 1)>(vb), m3 = tr_read<BO + v_rd_off<NCB>(D0 + 1, 3, 0)>(vb), n3 = tr_read<BO + v_rd_off<NCB>(D0 + 1, 3, 1)>(vb);
    asm volatile("s_waitcnt lgkmcnt(0)" ::: "memory"); SBAR();
#define PK(L, H) (bf16x8){L[0], L[1], L[2], L[3], H[0], H[1], H[2], H[3]}
    oa = __builtin_amdgcn_mfma_f32_32x32x16_bf16(pa0, PK(l0, h0), oa, 0, 0, 0); ob = __builtin_amdgcn_mfma_f32_32x32x16_bf16(pa0, PK(m0, n0), ob, 0, 0, 0);
    oa = __builtin_amdgcn_mfma_f32_32x32x16_bf16(pa1, PK(l1, h1), oa, 0, 0, 0); ob = __builtin_amdgcn_mfma_f32_32x32x16_bf16(pa1, PK(m1, n1), ob, 0, 0, 0);
    oa = __builtin_amdgcn_mfma_f32_32x32x16_bf16(pa2, PK(l2, h2), oa, 0, 0, 0); ob = __builtin_amdgcn_mfma_f32_32x32x16_bf16(pa2, PK(m2, n2), ob, 0, 0, 0);
    oa = __builtin_amdgcn_mfma_f32_32x32x16_bf16(pa3, PK(l3, h3), oa, 0, 0, 0); ob = __builtin_amdgcn_mfma_f32_32x32x16_bf16(pa3, PK(m3, n3), ob, 0, 0, 0);
#undef PK
}
struct VFrag { s16x4 l0, h0, l1, h1, l2, h2, l3, h3; };
template <int NCB, int D0> __device__ __forceinline__ void pv_reads(VFrag& f, int vb) {
    f.l0 = tr_read<v_rd_off<NCB>(D0, 0, 0)>(vb); f.h0 = tr_read<v_rd_off<NCB>(D0, 0, 1)>(vb); f.l1 = tr_read<v_rd_off<NCB>(D0, 1, 0)>(vb); f.h1 = tr_read<v_rd_off<NCB>(D0, 1, 1)>(vb);
    f.l2 = tr_read<v_rd_off<NCB>(D0, 2, 0)>(vb); f.h2 = tr_read<v_rd_off<NCB>(D0, 2, 1)>(vb); f.l3 = tr_read<v_rd_off<NCB>(D0, 3, 0)>(vb); f.h3 = tr_read<v_rd_off<NCB>(D0, 3, 1)>(vb);
}
__device__ __forceinline__ void pv_mfmas(f32x16& od, const VFrag& f, bf16x8 pa0, bf16x8 pa1, bf16x8 pa2, bf16x8 pa3) {
#define PK(L, H) (bf16x8){L[0], L[1], L[2], L[3], H[0], H[1], H[2], H[3]}
    od = __builtin_amdgcn_mfma_f32_32x32x16_bf16(pa0, PK(f.l0, f.h0), od, 0, 0, 0);
    od = __builtin_amdgcn_mfma_f32_32x32x16_bf16(pa1, PK(f.l1, f.h1), od, 0, 0, 0);
    od = __builtin_amdgcn_mfma_f32_32x32x16_bf16(pa2, PK(f.l2, f.h2), od, 0, 0, 0);
    od = __builtin_amdgcn_mfma_f32_32x32x16_bf16(pa3, PK(f.l3, f.h3), od, 0, 0, 0);
#undef PK
}
__device__ __forceinline__ void pack_p(const f32x16& p0, const f32x16& p1, bf16x8& pa0, bf16x8& pa1, bf16x8& pa2, bf16x8& pa3) {
#define PK4(P, BASE, OUT) do { unsigned a0 = cvtpk(P[BASE + 0], P[BASE + 1]), a1 = cvtpk(P[BASE + 2], P[BASE + 3]);   \
    unsigned b0 = cvtpk(P[BASE + 4], P[BASE + 5]), b1 = cvtpk(P[BASE + 6], P[BASE + 7]);                              \
    auto r0 = __builtin_amdgcn_permlane32_swap(a0, b0, false, false); auto r1 = __builtin_amdgcn_permlane32_swap(a1, b1, false, false); \
    u32x4 w = {r0[0], r1[0], r0[1], r1[1]}; OUT = *reinterpret_cast<bf16x8*>(&w); } while (0)
    PK4(p0, 0, pa0); PK4(p0, 8, pa1); PK4(p1, 0, pa2); PK4(p1, 8, pa3);
#undef PK4
}
struct Src {
    const bf16_t* q; int qpitch;
    const unsigned char* base;
    unsigned kA, kB, v; int nchA;
    int pitch; int T;
};
template <int DQK, int DV> struct Geo {
    static constexpr int NCHK = DQK / 8, NCHV = DV / 8, NCB = DV / 32, KSTR = DQK * 2 + 16, KBYTES = 64 * KSTR, VBYTES = 64 * DV * 2;
    static constexpr int BUFB = KBYTES + VBYTES, OFF_WS = 3 * BUFB;
    static constexpr int OFF_RED = OFF_WS + NWAVES * 64 * 4, BYTES = OFF_RED + NWAVES * 32 * 33 * 4;
    static constexpr int NK = 64 * NCHK, NV = 64 * NCHV, TOT = NK + NV, NPT = (TOT + NTHR - 1) / NTHR;
};
template <int DQK, int DV>
__device__ __forceinline__ void attn_pass(const Src& S, LAS unsigned char* lds, int tid, float C, f32x16 (&o)[DV / 32], float& l_out) {
    typedef Geo<DQK, DV> G;
    const int wid = __builtin_amdgcn_readfirstlane(tid >> 6), lane = tid & 63, r32 = lane & 31, hi = lane >> 5;
    const bool late = wid >= 4;
    LAS float* al_l = (LAS float*)(lds + G::OFF_WS) + wid * 64;
    bf16x8 qr[DQK / 16];
    { const bf16_t* Qw = S.q + (size_t)(wid * 32 + r32) * S.qpitch + hi * 8;
#pragma unroll
      for (int d0 = 0; d0 < DQK / 16; ++d0) qr[d0] = *(const bf16x8*)(Qw + d0 * 16); }
    const unsigned pitchB = (unsigned)S.pitch * 2u, stepB = pitchB * 64u;
    unsigned soff[G::NPT]; int sdst[G::NPT];
#pragma unroll
    for (int i = 0; i < G::NPT; ++i) { int idx = tid + NTHR * i; if (idx >= G::TOT) idx -= NTHR;
        if (idx < G::NK) { const int key = idx / G::NCHK, ch = idx - key * G::NCHK;
            soff[i] = S.kA + (unsigned)key * pitchB + ch * 16;
            if constexpr (DQK == QKA) { if (ch >= S.nchA) soff[i] = S.kB + (unsigned)key * pitchB + (ch - S.nchA) * 16; }
            sdst[i] = key * G::KSTR + ch * 16; }
        else { const int j = idx - G::NK, key = j / G::NCHV, ch = j - key * G::NCHV;
            soff[i] = S.v + (unsigned)key * pitchB + ch * 16; sdst[i] = G::KBYTES + v_st<G::NCB>(key, ch * 8); } }
    bf16x8 st[G::NPT];
#define FA_SLOAD(t) do { const unsigned char* bt_ = S.base + (size_t)(t) * stepB; _Pragma("unroll") for (int i = 0; i < G::NPT; ++i) st[i] = *(const bf16x8*)(bt_ + soff[i]); } while (0)
#define FA_SWRITE(bo_) do { _Pragma("unroll") for (int i = 0; i < G::NPT; ++i) *(LAS bf16x8*)(lds + sdst[i] + (bo_)) = st[i]; } while (0)
#define FA_QKT(bo_) do { p0 = f32x16{}; p1 = f32x16{}; LAS unsigned char* Ks_ = lds + (bo_); \
        _Pragma("unroll") for (int d0 = 0; d0 < DQK / 16; ++d0) { const int cb = (d0 * 16 + hi * 8) * 2; \
            const bf16x8 b0 = *(const LAS bf16x8*)(Ks_ + r32 * G::KSTR + cb), b1 = *(const LAS bf16x8*)(Ks_ + (32 + r32) * G::KSTR + cb); \
            p0 = __builtin_amdgcn_mfma_f32_32x32x16_bf16(b0, qr[d0], p0, 0, 0, 0); p1 = __builtin_amdgcn_mfma_f32_32x32x16_bf16(b1, qr[d0], p1, 0, 0, 0); } } while (0)
#define FA_LGKM(n) do { asm volatile("s_waitcnt lgkmcnt(" #n ")" ::: "memory"); SBAR(); } while (0)
#define FA_PV(bo_) do { const int vb_ = vb0 + (bo_); \
        if constexpr (DV == 128) { pv_two<G::NCB, 0, 0>(o[0], o[1], vb_, pa0, pa1, pa2, pa3); pv_two<G::NCB, 2, 0>(o[2], o[3], vb_, pa0, pa1, pa2, pa3); } \
        else { VFrag fa_, fb_; pv_reads<G::NCB, 0>(fa_, vb_); pv_reads<G::NCB, 1>(fb_, vb_); \
            FA_LGKM(8); pv_mfmas(o[0], fa_, pa0, pa1, pa2, pa3); SBAR(); FA_LGKM(0); pv_mfmas(o[1], fb_, pa0, pa1, pa2, pa3); } } while (0)
#define FA_SOFTMAX() do { float pmax = p0[0]; \
        _Pragma("unroll") for (int r = 1; r < 16; ++r) pmax = fmaxf(pmax, p0[r]); _Pragma("unroll") for (int r = 0; r < 16; ++r) pmax = fmaxf(pmax, p1[r]); \
        { auto rr = __builtin_amdgcn_permlane32_swap(__float_as_uint(pmax), __float_as_uint(pmax), false, false); pmax = fmaxf(__uint_as_float(rr[0]), __uint_as_float(rr[1])); } \
        float al_ = 1.f; \
        if (!__builtin_expect(__all(pmax - m_reg <= invC_thr), 1)) { const float mn = fmaxf(m_reg, pmax); al_ = __builtin_amdgcn_exp2f((m_reg - mn) * C); m_reg = mn; \
            if (hi == 0) al_l[r32] = al_; asm volatile("s_waitcnt lgkmcnt(0)" ::: "memory"); \
            _Pragma("unroll") for (int d = 0; d < DV / 32; ++d) _Pragma("unroll") for (int r = 0; r < 16; ++r) o[d][r] *= al_l[crow(r, hi)]; } \
        const float mnC = -m_reg * C; \
        _Pragma("unroll") for (int r = 0; r < 16; ++r) p0[r] = __builtin_amdgcn_exp2f(fmaf(p0[r], C, mnC)); _Pragma("unroll") for (int r = 0; r < 16; ++r) p1[r] = __builtin_amdgcn_exp2f(fmaf(p1[r], C, mnC)); \
        float ps = 0.f; _Pragma("unroll") for (int r = 0; r < 16; ++r) ps += p0[r]; _Pragma("unroll") for (int r = 0; r < 16; ++r) ps += p1[r]; \
        { auto rr = __builtin_amdgcn_permlane32_swap(__float_as_uint(ps), __float_as_uint(ps), false, false); ps = __uint_as_float(rr[0]) + __uint_as_float(rr[1]); } \
        l_reg = l_reg * al_ + ps; pack_p(p0, p1, pa0, pa1, pa2, pa3); } while (0)
#define FA_BAR() do { asm volatile("s_waitcnt lgkmcnt(0)" ::: "memory"); __builtin_amdgcn_s_barrier(); asm volatile("" ::: "memory"); } while (0)
    const int NT = S.T / 64;
    float m_reg = -1e30f, l_reg = 0.f;
#pragma unroll
    for (int d = 0; d < DV / 32; ++d) o[d] = f32x16{};
    const int vb0 = (int)(uintptr_t)(lds + G::KBYTES) + v_rd_base(lane);
    const float invC_thr = THR * 1.4426950408889634f / C;
    f32x16 p0, p1; bf16x8 pa0, pa1, pa2, pa3;
    FA_SLOAD(0); FA_SWRITE(0); FA_SLOAD(1); FA_BAR();
    if (late) __builtin_amdgcn_s_barrier();
    FA_SWRITE(G::BUFB); FA_SLOAD(2); SBAR(); FA_QKT(0); FA_BAR();
    FA_SOFTMAX(); FA_BAR();
    int bo_prev = 0, bo = G::BUFB, bo_next = 2 * G::BUFB;
#pragma unroll 1
    for (int t = 1; t < NT; ++t) {
        FA_SWRITE(bo_next); { const int tn = t + 2 < NT ? t + 2 : NT - 1; FA_SLOAD(tn); } SBAR();
        FA_QKT(bo); SBAR(); FA_PV(bo_prev);
        FA_BAR();
        FA_SOFTMAX();
        FA_BAR();
        bo_prev = bo; bo = bo_next; bo_next = bo_next == 2 * G::BUFB ? 0 : bo_next + G::BUFB;
    }
    FA_PV(bo_prev);
    if (!late) __builtin_amdgcn_s_barrier();
    FA_BAR();
    l_out = l_reg;
#undef FA_SLOAD
#undef FA_SWRITE
#undef FA_QKT
#undef FA_PV
#undef FA_LGKM
#undef FA_SOFTMAX
#undef FA_BAR
}
template <int NB> __device__ __forceinline__ void normalize(f32x16 (&o)[NB], float l_reg, LAS float* wsf, int r32, int hi, float mul) {
    if (hi == 0) wsf[32 + r32] = l_reg; asm volatile("s_waitcnt lgkmcnt(0)" ::: "memory");
#pragma unroll
    for (int r = 0; r < 16; ++r) { const float rl = mul * __builtin_amdgcn_rcpf(wsf[32 + crow(r, hi)]);
#pragma unroll
        for (int d = 0; d < NB; ++d) o[d][r] *= rl; }
    asm volatile("s_waitcnt lgkmcnt(0)" ::: "memory");
}
}

namespace ml {
using fa::f32x16; using fa::s16x4; using fa::crow; using fa::cvtpk; using fa::v_st; using fa::v_rd_base; using fa::v_rd_off; using fa::tr_read;
constexpr int WAVE_LDS = 16384;
constexpr int ARR_OFF = LDSCTL_OFF + 1024, ARR_WAVE = 1280;
static_assert(ARR_OFF + NWAVES * ARR_WAVE <= LDS_BYTES, "mlstm lds");
__device__ __forceinline__ bf16x8 pk4(const f32x16& P, int base_is_8) {
    unsigned a0, a1, b0, b1;
    if (base_is_8) { a0 = cvtpk(P[8], P[9]); a1 = cvtpk(P[10], P[11]); b0 = cvtpk(P[12], P[13]); b1 = cvtpk(P[14], P[15]); }
    else { a0 = cvtpk(P[0], P[1]); a1 = cvtpk(P[2], P[3]); b0 = cvtpk(P[4], P[5]); b1 = cvtpk(P[6], P[7]); }
    auto r0 = __builtin_amdgcn_permlane32_swap(a0, b0, false, false); auto r1 = __builtin_amdgcn_permlane32_swap(a1, b1, false, false);
    u32x4 w = {r0[0], r1[0], r0[1], r1[1]}; return *reinterpret_cast<bf16x8*>(&w);
}
template <int NCB, int D0, int KS> __device__ __forceinline__ bf16x8 tr_frag(int vb) {
    const s16x4 lo = tr_read<v_rd_off<NCB>(D0, KS, 0)>(vb), hi = tr_read<v_rd_off<NCB>(D0, KS, 1)>(vb);
    asm volatile("s_waitcnt lgkmcnt(0)" ::: "memory"); __builtin_amdgcn_sched_barrier(0);
    return (bf16x8){lo[0], lo[1], lo[2], lo[3], hi[0], hi[1], hi[2], hi[3]};
}
template <int NCB, int D0> __device__ __forceinline__ void tr_frag4(int vb, bf16x8& f0, bf16x8& f1, bf16x8& f2, bf16x8& f3) {
    const s16x4 l0 = tr_read<v_rd_off<NCB>(D0, 0, 0)>(vb), h0 = tr_read<v_rd_off<NCB>(D0, 0, 1)>(vb), l1 = tr_read<v_rd_off<NCB>(D0, 1, 0)>(vb), h1 = tr_read<v_rd_off<NCB>(D0, 1, 1)>(vb);
    const s16x4 l2 = tr_read<v_rd_off<NCB>(D0, 2, 0)>(vb), h2 = tr_read<v_rd_off<NCB>(D0, 2, 1)>(vb), l3 = tr_read<v_rd_off<NCB>(D0, 3, 0)>(vb), h3 = tr_read<v_rd_off<NCB>(D0, 3, 1)>(vb);
    asm volatile("s_waitcnt lgkmcnt(0)" ::: "memory"); __builtin_amdgcn_sched_barrier(0);
    f0 = (bf16x8){l0[0], l0[1], l0[2], l0[3], h0[0], h0[1], h0[2], h0[3]}; f1 = (bf16x8){l1[0], l1[1], l1[2], l1[3], h1[0], h1[1], h1[2], h1[3]};
    f2 = (bf16x8){l2[0], l2[1], l2[2], l2[3], h2[0], h2[1], h2[2], h2[3]}; f3 = (bf16x8){l3[0], l3[1], l3[2], l3[3], h3[0], h3[1], h3[2], h3[3]};
}
#define ML_DPP(ident, v, ctrl, rmask) __int_as_float(__builtin_amdgcn_update_dpp(__float_as_int(ident), __float_as_int(v), ctrl, rmask, 0xf, false))
__device__ __forceinline__ float scan_add(float x, int lane) {
    x += ML_DPP(0.f, x, 0x111, 0xf); x += ML_DPP(0.f, x, 0x112, 0xf); x += ML_DPP(0.f, x, 0x114, 0xf); x += ML_DPP(0.f, x, 0x118, 0xf);
    x += ML_DPP(0.f, x, 0x142, 0xa); x += ML_DPP(0.f, x, 0x143, 0xc);
    return x;
}
__device__ __forceinline__ float scan_max(float x, int lane) {
    const float ni = -3.0e38f;
    x = fmaxf(x, ML_DPP(ni, x, 0x111, 0xf)); x = fmaxf(x, ML_DPP(ni, x, 0x112, 0xf)); x = fmaxf(x, ML_DPP(ni, x, 0x114, 0xf)); x = fmaxf(x, ML_DPP(ni, x, 0x118, 0xf));
    x = fmaxf(x, ML_DPP(ni, x, 0x142, 0xa)); x = fmaxf(x, ML_DPP(ni, x, 0x143, 0xc));
    return x;
}
template <bool STATE_ONLY>
__device__ __forceinline__ void wave_task(Frame& F, int l, int pb, int dir, int head, int sl, int seg) {
    const int lane = F.lane, r32 = lane & 31, hi = lane >> 5, wave = F.wave;
    const bool lat = pb >= CB; const int b = lat ? pb - CB : pb; const int N = lat ? LS : CS; const int row0 = lat ? NCTX + b * LS : b * CS;
    const int c0 = lat ? seg * ML_SEGCH : 0, c1 = lat ? c0 + ML_SEGCH : CS / 64;
    LAS unsigned char* wl = F.lds + wave * WAVE_LDS;
    LAS unsigned char* KT = wl; LAS unsigned char* VT = wl + 8192; LAS unsigned char* VW = wl + 12288;
    LAS float* gL = (LAS float*)(F.lds + ARR_OFF + wave * ARR_WAVE); LAS float* ML = gL + 64; LAS float* wiL = gL + 128; LAS float* bL = gL + 192;
    const int kt_rd = (int)(uintptr_t)KT + v_rd_base(lane), vt_rd = (int)(uintptr_t)VT + v_rd_base(lane), vw_rd = (int)(uintptr_t)VW + v_rd_base(lane);
    const bf16_t* MQ = F.wsp<bf16_t>(WS_MQKVO); const float* MG = F.wsp<float>(WS_MG);
    const size_t sbase = ((size_t)(b * DEPTH + l) * 2 + dir) * HM + head;
    float* slab0 = F.wsp<float>(WS_SLAB) + ((size_t)(((b * 2 + dir) * HM + head) * 5 + sl) * ML_NSEG) * SLAB_F;
    f32x16 Cacc[2]; float m; float bsum = 0.f;
    if (STATE_ONLY) { m = -1e30f; Cacc[0] = f32x16{}; Cacc[1] = f32x16{}; }
    else if (lat) {
        m = F.inp(I_SM)[sbase];
#pragma unroll
        for (int db = 0; db < 2; ++db)
#pragma unroll
            for (int r = 0; r < 16; ++r) { const int d = 32 * db + crow(r, hi);
                Cacc[db][r] = sl < 4 ? F.inp(I_SC)[(sbase * 64 + d) * 128 + sl * 32 + r32] : F.inp(I_SN)[sbase * 64 + d]; }
#pragma unroll 1
        for (int sp0 = 0; sp0 < seg; sp0 += 4) {
            float sv[4][32], sm_[4], sbs_[4];
#pragma unroll
            for (int k = 0; k < 4; ++k) { const int sp = sp0 + k < seg ? sp0 + k : seg - 1; const float* sb_ = slab0 + (size_t)sp * SLAB_F; sm_[k] = sb_[2048]; sbs_[k] = sb_[2049];
#pragma unroll
                for (int q = 0; q < 32; ++q) sv[k][q] = sb_[q * 64 + lane]; }
#pragma unroll
            for (int k = 0; k < 4; ++k) if (sp0 + k < seg) {
                const float mn = fmaxf(m + sbs_[k], sm_[k]), w0 = __expf(m + sbs_[k] - mn), w1 = __expf(sm_[k] - mn);
#pragma unroll
                for (int db = 0; db < 2; ++db)
#pragma unroll
                    for (int r = 0; r < 16; ++r) Cacc[db][r] = w0 * Cacc[db][r] + w1 * sv[k][db * 16 + r];
                m = mn; } }
    } else { m = 0.f; Cacc[0] = f32x16{}; Cacc[1] = f32x16{}; }
#pragma unroll 1
    for (int c = c0; c < c1; ++c) {
        const int tau = c * 64 + lane, t = dir ? N - 1 - tau : tau; const size_t row = (size_t)(row0 + t);
        const float li = MG[row * 16 + dir * 4 + head], gf_ = MG[row * 16 + 8 + dir * 4 + head];
        const float lf = fminf(gf_, 0.f) - 0.6931471805599453f * __builtin_amdgcn_logf(1.f + __builtin_amdgcn_exp2f(-1.4426950408889634f * fabsf(gf_)));
#pragma unroll
        for (int ch = 0; ch < 8; ++ch) *(LAS u32x4*)(KT + v_st<2>(lane, ch * 8)) = *(const u32x4*)(MQ + row * 1536 + 256 + head * 64 + ch * 8);
        u32x4 vraw[4];
        if (sl < 4) {
#pragma unroll
            for (int ch = 0; ch < 4; ++ch) vraw[ch] = *(const u32x4*)(MQ + row * 1536 + 512 + head * 128 + sl * 32 + ch * 8);
        } else {
#pragma unroll
            for (int ch = 0; ch < 4; ++ch) vraw[ch] = (u32x4){0x3f803f80u, 0x3f803f80u, 0x3f803f80u, 0x3f803f80u};
        }
        bf16x8 qf[2][4];
        if (!STATE_ONLY)
#pragma unroll
        for (int ib = 0; ib < 2; ++ib) { const int tq = c * 64 + 32 * ib + r32, tt = dir ? N - 1 - tq : tq; const bf16_t* qp = MQ + (size_t)(row0 + tt) * 1536 + head * 64 + hi * 8;
#pragma unroll
            for (int ks = 0; ks < 4; ++ks) qf[ib][ks] = *(const bf16x8*)(qp + ks * 16); }
        const float bcum = scan_add(lf, lane), g = li - bcum, pm = scan_max(g, lane), Mi = fmaxf(m, pm);
        const float M63 = __int_as_float(__builtin_amdgcn_readlane(__float_as_int(Mi), 63)), b63 = __int_as_float(__builtin_amdgcn_readlane(__float_as_int(bcum), 63));
        const float wi = __expf(m - Mi), wsl = __expf(g - M63), wold = __expf(m - M63);
        gL[lane] = g; ML[lane] = Mi; wiL[lane] = wi; bL[lane] = bcum;
#pragma unroll
        for (int ch = 0; ch < 4; ++ch) { if (!STATE_ONLY) *(LAS u32x4*)(VT + v_st<1>(lane, ch * 8)) = vraw[ch];
            u32x4 w;
#pragma unroll
            for (int e = 0; e < 4; ++e) w[e] = pk2(lo_bf(vraw[ch][e]) * wsl, hi_bf(vraw[ch][e]) * wsl);
            *(LAS u32x4*)(VW + v_st<1>(lane, ch * 8)) = w; }
        asm volatile("s_waitcnt lgkmcnt(0)" ::: "memory");
        if (!STATE_ONLY) {
        bf16x8 a00[2], a01[2], a11[2];
        { f32x16 P00 = f32x16{}, P01 = f32x16{}, P11 = f32x16{};
#pragma unroll
          for (int ks = 0; ks < 4; ++ks) {
              const bf16x8 k0 = *(const LAS bf16x8*)(KT + v_st<2>(r32, ks * 16 + hi * 8)), k1 = *(const LAS bf16x8*)(KT + v_st<2>(32 + r32, ks * 16 + hi * 8));
              P00 = __builtin_amdgcn_mfma_f32_32x32x16_bf16(k0, qf[0][ks], P00, 0, 0, 0);
              P01 = __builtin_amdgcn_mfma_f32_32x32x16_bf16(k0, qf[1][ks], P01, 0, 0, 0);
              P11 = __builtin_amdgcn_mfma_f32_32x32x16_bf16(k1, qf[1][ks], P11, 0, 0, 0);
          }
          const float M0 = ML[r32], M1 = ML[32 + r32];
#pragma unroll
          for (int q = 0; q < 4; ++q) { const f32x4 g0 = *(const LAS f32x4*)(gL + 8 * q + 4 * hi), g1 = *(const LAS f32x4*)(gL + 32 + 8 * q + 4 * hi);
#pragma unroll
              for (int j = 0; j < 4; ++j) { const int r = 4 * q + j; const int sl_ = j + 8 * q + 4 * hi;
                  P00[r] = (sl_ <= r32) ? P00[r] * __expf(g0[j] - M0) : 0.f;
                  P01[r] = P01[r] * __expf(g0[j] - M1);
                  P11[r] = (sl_ <= r32) ? P11[r] * __expf(g1[j] - M1) : 0.f; } }
          a00[0] = pk4(P00, 0); a00[1] = pk4(P00, 1); a01[0] = pk4(P01, 0); a01[1] = pk4(P01, 1); a11[0] = pk4(P11, 0); a11[1] = pk4(P11, 1); }
        f32x16 Y0 = f32x16{}, Y1 = f32x16{};
#pragma unroll
        for (int db = 0; db < 2; ++db)
#pragma unroll
            for (int kk = 0; kk < 2; ++kk) { const bf16x8 cf = pk4(Cacc[db], kk);
                Y0 = __builtin_amdgcn_mfma_f32_32x32x16_bf16(qf[0][2 * db + kk], cf, Y0, 0, 0, 0);
                Y1 = __builtin_amdgcn_mfma_f32_32x32x16_bf16(qf[1][2 * db + kk], cf, Y1, 0, 0, 0); }
#pragma unroll
        for (int q = 0; q < 4; ++q) { const f32x4 w0 = *(const LAS f32x4*)(wiL + 8 * q + 4 * hi), w1 = *(const LAS f32x4*)(wiL + 32 + 8 * q + 4 * hi);
#pragma unroll
            for (int j = 0; j < 4; ++j) { Y0[4 * q + j] *= w0[j]; Y1[4 * q + j] *= w1[j]; } }
        { bf16x8 v0, v1, v2, v3; tr_frag4<1, 0>(vt_rd, v0, v1, v2, v3);
          Y0 = __builtin_amdgcn_mfma_f32_32x32x16_bf16(a00[0], v0, Y0, 0, 0, 0); Y0 = __builtin_amdgcn_mfma_f32_32x32x16_bf16(a00[1], v1, Y0, 0, 0, 0);
          Y1 = __builtin_amdgcn_mfma_f32_32x32x16_bf16(a01[0], v0, Y1, 0, 0, 0); Y1 = __builtin_amdgcn_mfma_f32_32x32x16_bf16(a01[1], v1, Y1, 0, 0, 0);
          Y1 = __builtin_amdgcn_mfma_f32_32x32x16_bf16(a11[0], v2, Y1, 0, 0, 0); Y1 = __builtin_amdgcn_mfma_f32_32x32x16_bf16(a11[1], v3, Y1, 0, 0, 0); }
        { const int rstep = dir ? -512 : 512; const int tb = dir ? N - 1 - c * 64 : c * 64;
          if (sl < 4) {
            bf16_t* H = F.wsp<bf16_t>(dir ? WS_HB : WS_HF) + (size_t)row0 * 512 + head * 128 + sl * 32;
            int off = tb * 512 + r32 + rstep * (4 * hi);
#pragma unroll
            for (int r = 0; r < 16; ++r) { const int o0 = off + rstep * ((r & 3) + 8 * (r >> 2));
                H[o0] = (bf16_t)f2bf(Y0[r]); H[o0 + rstep * 32] = (bf16_t)f2bf(Y1[r]); }
          } else if (r32 == 0) {
            float* DN = F.wsp<float>(WS_DEN) + (size_t)row0 * 8 + dir * 4 + head; const int rs8 = dir ? -8 : 8;
#pragma unroll
            for (int r = 0; r < 16; ++r) { const int il = crow(r, hi); const int o0 = tb * 8 + rs8 * il;
                DN[o0] = fmaxf(fabsf(Y0[r]), __expf(-(bL[il] + ML[il]))); DN[o0 + rs8 * 32] = fmaxf(fabsf(Y1[r]), __expf(-(bL[32 + il] + ML[32 + il]))); }
          } }
        }
#pragma unroll
        for (int r = 0; r < 16; ++r) { Cacc[0][r] *= wold; Cacc[1][r] *= wold; }
        { bf16x8 w0, w1, w2, w3, k0, k1, k2, k3; tr_frag4<1, 0>(vw_rd, w0, w1, w2, w3); tr_frag4<2, 0>(kt_rd, k0, k1, k2, k3);
          Cacc[0] = __builtin_amdgcn_mfma_f32_32x32x16_bf16(k0, w0, Cacc[0], 0, 0, 0); Cacc[0] = __builtin_amdgcn_mfma_f32_32x32x16_bf16(k1, w1, Cacc[0], 0, 0, 0);
          Cacc[0] = __builtin_amdgcn_mfma_f32_32x32x16_bf16(k2, w2, Cacc[0], 0, 0, 0); Cacc[0] = __builtin_amdgcn_mfma_f32_32x32x16_bf16(k3, w3, Cacc[0], 0, 0, 0);
          tr_frag4<2, 1>(kt_rd, k0, k1, k2, k3);
          Cacc[1] = __builtin_amdgcn_mfma_f32_32x32x16_bf16(k0, w0, Cacc[1], 0, 0, 0); Cacc[1] = __builtin_amdgcn_mfma_f32_32x32x16_bf16(k1, w1, Cacc[1], 0, 0, 0);
          Cacc[1] = __builtin_amdgcn_mfma_f32_32x32x16_bf16(k2, w2, Cacc[1], 0, 0, 0); Cacc[1] = __builtin_amdgcn_mfma_f32_32x32x16_bf16(k3, w3, Cacc[1], 0, 0, 0); }
        m = b63 + M63; bsum += b63;
        asm volatile("s_waitcnt lgkmcnt(0)" ::: "memory");
    }
    if (STATE_ONLY) {
        float* sb_ = slab0 + (size_t)seg * SLAB_F;
#pragma unroll
        for (int db = 0; db < 2; ++db)
#pragma unroll
            for (int r = 0; r < 16; ++r) sb_[(db * 16 + r) * 64 + lane] = Cacc[db][r];
        if (lane == 0) { sb_[2048] = m; sb_[2049] = bsum; }
    } else if (!lat) {
        if (sl < 4) {
#pragma unroll
            for (int db = 0; db < 2; ++db)
#pragma unroll
                for (int r = 0; r < 16; ++r) F.out[O_C + (sbase * 64 + 32 * db + crow(r, hi)) * 128 + sl * 32 + r32] = Cacc[db][r];
        } else if (r32 == 0) {
#pragma unroll
            for (int db = 0; db < 2; ++db)
#pragma unroll
                for (int r = 0; r < 16; ++r) F.out[O_N + sbase * 64 + 32 * db + crow(r, hi)] = Cacc[db][r];
            if (lane == 0) F.out[O_M + sbase] = m;
        }
    }
}
constexpr int NLAT_TASKS = LB * 2 * HM * 5 * ML_NSEG;
constexpr int NLAT_GROUPS = NLAT_TASKS / 8, NCTX_GROUPS = (CB * 2 * HM * 5) / 8;
constexpr int NPRE_GROUPS = (LB * 2 * HM * 5 * (ML_NSEG - 1)) / 8;
__device__ __forceinline__ void task_group_lat(Frame& F, int l, int grp) {
    const int task = grp * 8 + F.wave, seg = task / 80, rem = task - seg * 80, stream = rem / 5, sl = rem - stream * 5;
    wave_task<false>(F, l, CB + (stream >> 3), (stream >> 2) & 1, stream & 3, sl, seg);
    __syncthreads();
}
__device__ __forceinline__ void task_group_pre(Frame& F, int l, int grp) {
    const int task = grp * 8 + F.wave, seg = task / 80, rem = task - seg * 80, stream = rem / 5, sl = rem - stream * 5;
    wave_task<true>(F, l, CB + (stream >> 3), (stream >> 2) & 1, stream & 3, sl, seg);
    __syncthreads();
}
__device__ __forceinline__ void task_group_ctx(Frame& F, int l, int grp) {
    const int task = grp * 8 + F.wave, stream = task / 5, sl = task - stream * 5;
    wave_task<false>(F, l, stream >> 3, (stream >> 2) & 1, stream & 3, sl, 0);
    __syncthreads();
}
}

constexpr int NDIFF_UNITS = 192, NMLA_UNITS = 384;
__device__ __forceinline__ void attn_unit_mla(Frame& F, int l, int item) {
    using namespace fa;
    const int tid = F.tid, wid = tid >> 6, lane = tid & 63, r32 = lane & 31, hi = lane >> 5;
    bool lat; int b, h, qb;
    if (item < 256) { lat = true; b = item >> 7; h = (item >> 4) & 7; qb = item & 15; }
    else { const int i = item - 256; lat = false; b = i >> 3; h = i & 7; qb = 0; }
    const int row0 = lat ? NCTX + b * LS + qb * 256 : b * CS;
    const int key0 = lat ? NCTX + b * LT : b * CS; const int T = lat ? LT : CS;
    typedef Geo<QKA, VA> G; LAS float* wsf = (LAS float*)(F.lds + G::OFF_WS) + wid * 64;
    const unsigned kv0 = (unsigned)WS_KV + ((unsigned)key0 * KVP + h * 128) * 2u;
    Src S{F.wsp<bf16_t>(WS_QA) + (size_t)row0 * 768 + h * QKA, 768, F.ws, kv0, (unsigned)WS_KV + ((unsigned)key0 * KVP + 1024) * 2u, kv0 + 128u, NOPE / 8, KVP, T};
    f32x16 o[2]; float lsum;
    attn_pass<QKA, VA>(S, F.lds, tid, 0.10206207261596577f * 1.4426950408889634f, o, lsum);
    normalize<2>(o, lsum, wsf, r32, hi, 1.f);
    bf16_t* O = F.wsp<bf16_t>(WS_OA) + (size_t)(row0 + wid * 32) * 512 + h * 64 + r32;
#pragma unroll
    for (int r = 0; r < 16; ++r) { const int orow = crow(r, hi);
#pragma unroll
        for (int d = 0; d < 2; ++d) O[(size_t)orow * 512 + d * 32] = (bf16_t)f2bf(o[d][r]); }
    { asm volatile("s_waitcnt lgkmcnt(0)" ::: "memory"); __builtin_amdgcn_s_barrier(); asm volatile("" ::: "memory"); }
}
__device__ __forceinline__ void attn_unit_diff(Frame& F, int l, int item) {
    using namespace fa;
    const int tid = F.tid, wid = tid >> 6, lane = tid & 63, r32 = lane & 31, hi = lane >> 5;
    bool lat; int b, h, qb;
    if (item < 128) { lat = true; b = item >> 6; h = (item >> 4) & 3; qb = item & 15; }
    else { const int i = item - 128; lat = false; b = i >> 2; h = i & 3; qb = 0; }
    const int row0 = lat ? NCTX + b * LS + qb * 256 : b * CS;
    const int key0 = lat ? NCTX + b * LT : b * CS; const int T = lat ? LT : CS;
    typedef Geo<DKD, DVD> G; LAS float* wsf = (LAS float*)(F.lds + G::OFF_WS) + wid * 64; LAS float* red = (LAS float*)(F.lds + G::OFF_RED) + wid * 32 * 33;
    const float lam = F.smallf()[SM_LAM + l * 2], lam_init = F.smallf()[SM_LAM + l * 2 + 1];
    bf16_t* DQp = F.wsp<bf16_t>(WS_DQ) + (size_t)row0 * 512 + h * 128;
    f32x16 o2[4]; float lsum;
    bf16_t* Stash = F.wsp<bf16_t>(WS_OM) + (size_t)(row0 + wid * 32) * 512 + h * 128 + r32;
    { Src S{DQp, 512, F.ws, (unsigned)WS_DK + ((unsigned)key0 * 512 + h * 128) * 2u, 0u, (unsigned)WS_DV + ((unsigned)key0 * 512 + h * 128) * 2u, 8, 512, T};
      attn_pass<DKD, DVD>(S, F.lds, tid, 0.125f * 1.4426950408889634f, o2, lsum); normalize<4>(o2, lsum, wsf, r32, hi, 1.f);
#pragma unroll
      for (int r = 0; r < 16; ++r) { const int orow = crow(r, hi);
#pragma unroll
          for (int d = 0; d < 4; ++d) Stash[(size_t)orow * 512 + d * 32] = (bf16_t)f2bf(o2[d][r]); } }
    { Src S{DQp + 64, 512, F.ws, (unsigned)WS_DK + ((unsigned)key0 * 512 + h * 128 + 64) * 2u, 0u, (unsigned)WS_DV + ((unsigned)key0 * 512 + h * 128) * 2u, 8, 512, T};
      attn_pass<DKD, DVD>(S, F.lds, tid, 0.125f * 1.4426950408889634f, o2, lsum); normalize<4>(o2, lsum, wsf, r32, hi, lam); }
#pragma unroll
    for (int rh = 0; rh < 16; rh += 4) { unsigned sv_[4][4];
#pragma unroll
      for (int r = 0; r < 4; ++r)
#pragma unroll
          for (int d = 0; d < 4; ++d) sv_[r][d] = Stash[(size_t)crow(rh + r, hi) * 512 + d * 32];
#pragma unroll
      for (int r = 0; r < 4; ++r) { float ss = 0.f; const int orow = crow(rh + r, hi);
#pragma unroll
          for (int d = 0; d < 4; ++d) { o2[d][rh + r] = bf2f((bf16_t)sv_[r][d]) - o2[d][rh + r]; ss += o2[d][rh + r] * o2[d][rh + r]; }
          red[orow * 33 + r32] = ss; }
      asm volatile("" ::: "memory"); }
    asm volatile("s_waitcnt lgkmcnt(0)" ::: "memory");
    float tot = 0.f;
#pragma unroll
    for (int c = 0; c < 16; ++c) tot += red[r32 * 33 + hi * 16 + c];
    { auto rr = __builtin_amdgcn_permlane32_swap(__float_as_uint(tot), __float_as_uint(tot), false, false); tot = __uint_as_float(rr[0]) + __uint_as_float(rr[1]); }
    if (hi == 0) wsf[r32] = rsqrtf(tot * (1.f / DVD) + EPS) * (1.f - lam_init);
    asm volatile("s_waitcnt lgkmcnt(0)" ::: "memory");
    const float* g = F.inp(I_DNG) + l * 512 + h * 128 + r32; float gv[4];
#pragma unroll
    for (int d = 0; d < 4; ++d) gv[d] = g[d * 32];
    bf16_t* O = DQp + (size_t)(wid * 32) * 512 + r32;
#pragma unroll
    for (int r = 0; r < 16; ++r) { const int orow = crow(r, hi); const float rs = wsf[orow];
#pragma unroll
        for (int d = 0; d < 4; ++d) O[(size_t)orow * 512 + d * 32] = (bf16_t)f2bf(o2[d][r] * rs * gv[d]); }
    { asm volatile("s_waitcnt lgkmcnt(0)" ::: "memory"); __builtin_amdgcn_s_barrier(); asm volatile("" ::: "memory"); }
}
#define LDS_BAR() do { asm volatile("s_waitcnt lgkmcnt(0)" ::: "memory"); __builtin_amdgcn_s_barrier(); asm volatile("" ::: "memory"); } while (0)
#define QUEUE_LOOP(QI, NITEMS, CALL) for (;;) { \
        if (F.tid == 0) *slot = (int)__hip_atomic_fetch_add((unsigned*)(F.ws + WS_CTL) + CW_QUEUE + (l * 8 + (QI)) * 64, 1u, __ATOMIC_RELAXED, __HIP_MEMORY_SCOPE_AGENT); \
        LDS_BAR(); const int item = *slot; LDS_BAR(); if (item >= (NITEMS)) break; asm volatile("" : "+v"(F.tid), "+v"(F.lane)); CALL; }
__device__ __forceinline__ void phase_attn(Frame& F, int l) {
    volatile LAS int* slot = (volatile LAS int*)(F.lds + MISC_OFF) + 16;
#ifndef USE_MLSTM_REF
    QUEUE_LOOP(0, ml::NLAT_GROUPS, ml::task_group_lat(F, l, item))
#endif
#ifndef NO_ATTN
    QUEUE_LOOP(1, NDIFF_UNITS, attn_unit_diff(F, l, item))
    QUEUE_LOOP(2, NMLA_UNITS, attn_unit_mla(F, l, item))
#endif
#ifndef USE_MLSTM_REF
    QUEUE_LOOP(3, ml::NCTX_GROUPS, ml::task_group_ctx(F, l, item))
#endif
    QUEUE_LOOP(5, CONV_CHUNKS, convert_late_chunk(F, l, item))
}

__device__ __forceinline__ void phase_om(Frame& F, int l, int wi, int nw) {
    const int gw = wi * NWAVES + F.wave, NGW = nw * NWAVES; const int lane = F.lane, head = lane >> 4, c = lane * 8;
    float g[8];
    { const f32x4 g0 = *(const f32x4*)(F.inp(I_MNG) + l * 512 + c), g1 = *(const f32x4*)(F.inp(I_MNG) + l * 512 + c + 4);
#pragma unroll
      for (int e = 0; e < 4; ++e) { g[e] = g0[e]; g[4 + e] = g1[e]; } }
    constexpr int NB = 4;
    for (int row0 = gw; row0 < M; row0 += NGW * NB) {
        u32x4 fw[NB], bw[NB], mw[NB]; float df[NB], db[NB];
#pragma unroll
        for (int i = 0; i < NB; ++i) { const size_t row = (size_t)min(row0 + i * NGW, M - 1);
            fw[i] = *(const u32x4*)(F.wsp<bf16_t>(WS_HF) + row * 512 + c); bw[i] = *(const u32x4*)(F.wsp<bf16_t>(WS_HB) + row * 512 + c);
            mw[i] = *(const u32x4*)(F.wsp<bf16_t>(WS_MQKVO) + row * 1536 + 1024 + c);
            const float* dn = F.wsp<float>(WS_DEN) + row * 8; df[i] = dn[head]; db[i] = dn[4 + head]; }
#pragma unroll
        for (int i = 0; i < NB; ++i) { const int row = row0 + i * NGW; const float rf = 1.f / df[i], rb = 1.f / db[i];
            float hf[8], hb[8], m8[8], h[8];
            UNPACK8(hf, 0, fw[i]); UNPACK8(hb, 0, bw[i]); UNPACK8(m8, 0, mw[i]);
            float ss = 0.f;
#pragma unroll
            for (int e = 0; e < 8; ++e) { h[e] = hf[e] * rf + hb[e] * rb; ss += h[e] * h[e]; }
            ss += lane_xor(ss, 1, lane); ss += lane_xor(ss, 2, lane); ss += lane_xor(ss, 4, lane); ss += lane_xor(ss, 8, lane);
            const float rs = rsqrtf(ss * (1.f / DVM) + EPS);
#pragma unroll
            for (int e = 0; e < 8; ++e) h[e] = h[e] * rs * g[e] * sigmoidf_(m8[e]);
            u32x4 w; w.x = pk2(h[0], h[1]); w.y = pk2(h[2], h[3]); w.z = pk2(h[4], h[5]); w.w = pk2(h[6], h[7]);
            if (row < M) *(u32x4*)(F.wsp<bf16_t>(WS_OM) + (size_t)row * 512 + c) = w; }
    }
}
__device__ __forceinline__ void phase_norm2(Frame& F, int l) {
    const int gw = F.bid * NWAVES + F.wave, NGW = F.G * NWAVES;
    for (int row = gw; row < M; row += NGW * 3) rmsmod_rows<false, 3>(F, l, row, NGW, F.inp(I_N2G) + l * D, 4, 3);
}
__device__ __forceinline__ void phase_final(Frame& F) {
    const int gw = F.bid * NWAVES + F.wave, NGW = F.G * NWAVES; const float* g = F.inp(I_FNG);
    constexpr int NB = 6;
    f32x4 gg[4];
#pragma unroll
    for (int j = 0; j < 4; ++j) gg[j] = *(const f32x4*)(g + 4 * F.lane + 256 * j);
    for (int row0 = gw; row0 < M; row0 += NGW * NB) { u32x2 xw[NB][4];
#pragma unroll
        for (int i = 0; i < NB; ++i) { const bf16_t* x = F.wsp<bf16_t>(WS_H) + (size_t)min(row0 + i * NGW, M - 1) * D;
#pragma unroll
            for (int j = 0; j < 4; ++j) xw[i][j] = *(const u32x2*)(x + 4 * F.lane + 256 * j); }
#pragma unroll
        for (int i = 0; i < NB; ++i) { const int row = row0 + i * NGW; f32x4 v[4]; float s = 0.f;
#pragma unroll
            for (int j = 0; j < 4; ++j) { const u32x2 w = xw[i][j]; v[j] = (f32x4){lo_bf(w.x), hi_bf(w.x), lo_bf(w.y), hi_bf(w.y)}; s += (v[j][0] * v[j][0] + v[j][1] * v[j][1]) + (v[j][2] * v[j][2] + v[j][3] * v[j][3]); }
            const float r = rsqrtf(wave_sum(s, F.lane) * (1.f / D) + EPS);
            if (row < M) { float* y = F.out + O_X + (size_t)row * D;
#pragma unroll
                for (int j = 0; j < 4; ++j) *(f32x4*)(y + 4 * F.lane + 256 * j) = v[j] * r * gg[j]; } } }
}

#ifdef USE_GEMM_REF
#define GEMM_PHASE gemm_ref
#else
#define GEMM_PHASE pg8::gemm_phase<4>
#define GEMM_PHASE3 pg8::gemm_phase<3>
#endif
constexpr int PH_PER_LAYER = 10, N_PHASES = 1 + DEPTH * PH_PER_LAYER + 1;
__global__ void __launch_bounds__(NTHR, 2) mega_fwd(Args args) {
    extern __shared__ __attribute__((aligned(16))) unsigned char lds_raw[];
    Frame F; F.lds = (LAS unsigned char*)lds_raw; F.tid = threadIdx.x; F.lane = F.tid & 63; F.wave = __builtin_amdgcn_readfirstlane(F.tid >> 6);
    F.G = gridDim.x; F.bid = blockIdx.x; F.out = opaque_ptr(args.out); F.ws = opaque_ptr(args.ws);
    F.ka = (const __attribute__((address_space(4))) Args*)__builtin_amdgcn_kernarg_segment_ptr();
    for (int u = F.tid; u < (LDS_BYTES - LDSCTL_OFF) / 4; u += NTHR) ((LAS unsigned*)(F.lds + LDSCTL_OFF))[u] = 0u;
    __syncthreads();
    XcdBarrier bar = xcd_barrier_post((unsigned*)(F.ws + WS_CTL) + CW_BAR + args.li * XCD_BAR_WORDS, (volatile LAS unsigned*)(F.lds + MISC_OFF) + 8);
    const int lo = args.ph_lo, hi = args.ph_hi;
#ifndef PHMASK
#define PHMASK 0xFFFFFFFFu
#endif
#define PHBIT(k) ((k) == 0 ? 0 : (k) == N_PHASES - 1 ? 11 : (((k) - 1) % PH_PER_LAYER) + 1)
#define IN(k) (((PHMASK >> PHBIT(k)) & 1u) && lo <= (k) && (k) < hi)
#define SEAM(k) do { if (IN(k) && IN((k) + 1)) xcd_barrier(bar); asm volatile("" : "+v"(F.tid), "+v"(F.lane)); F.ws = opaque_ptr(F.ws); F.out = opaque_ptr(F.out); F.G = opaque_int(F.G); F.bid = opaque_int(F.bid); } while (0)
    if (IN(0)) { phase_mod(F); convert_set<0>(F, 0, F.bid * NWAVES + F.wave, F.G * NWAVES); } SEAM(0);
#pragma unroll 1
    for (int l = 0; l < DEPTH; ++l) {
        const int pb = 1 + l * PH_PER_LAYER;
        float* ssq = (float*)(F.ws + WS_CTL) + CW_SSQ + l * M; float* sskv = (float*)(F.ws + WS_CTL) + CW_SSKV + l * M;
        if (IN(pb + 0)) { phase_layer_prep(F, l); } SEAM(pb + 0);
        if (IN(pb + 1)) {
            ProbSimple P{F.wsp<bf16_t>(WS_H), F.wsp<bf16_t>(WS_WIN), D}; TileOrder S; S.init(M / BM, ZN / BM, F.G, F.bid);
            EpiZ E{l, F.ws, F.out, F.inp(I_GATEB)};
            GEMM_PHASE(F.lds, F.tid, P, S, E);
        } SEAM(pb + 1);
        if (IN(pb + 2)) {
            { ProbSimple P{F.wsp<bf16_t>(WS_ACQ), F.wsp<bf16_t>(WS_WQ), QR}; TileOrder S; S.init(M / BM, 768 / BM, F.G, F.bid);
              EpiQ E{F.wsp<bf16_t>(WS_QA), ssq, F.smallf() + SM_TA}; GEMM_PHASE(F.lds, F.tid, P, S, E); }
            { ProbSimple P{F.wsp<bf16_t>(WS_ACKV), F.wsp<bf16_t>(WS_WKVG), KVR}; TileOrder S; S.init(M / BM, 1024 / BM, F.G, (F.bid + 144) % F.G);
              EpiKV E{F.wsp<bf16_t>(WS_KV), sskv, 0}; GEMM_PHASE(F.lds, F.tid, P, S, E); }
            { ProbSimple P{F.wsp<bf16_t>(WS_CKVC), F.wsp<bf16_t>(WS_WKV), KVR}; TileOrder S; S.init(LB * PAST / BM, 1024 / BM, F.G, (F.bid + 80) % F.G);
              EpiKV E{F.wsp<bf16_t>(WS_KV), sskv, 1}; GEMM_PHASE(F.lds, F.tid, P, S, E); }
            phase_ckv_out(F, l);
            { volatile LAS int* slot = (volatile LAS int*)(F.lds + MISC_OFF) + 16; QUEUE_LOOP(4, ml::NPRE_GROUPS, ml::task_group_pre(F, l, item)) }
        } SEAM(pb + 2);
        if (IN(pb + 3)) {
#ifdef USE_MLSTM_REF
            mlstm_ref(F, l);
#endif
            phase_attn(F, l);
        } SEAM(pb + 3);
        if (IN(pb + 4)) {
            ProbSimple P{F.wsp<bf16_t>(WS_H), F.wsp<bf16_t>(WS_WIN) + (size_t)ZN * D, D}; TileOrder S; S.init(M / BM, GN / BM, F.G, F.bid);
            EpiGate E{F.wsp<bf16_t>(WS_GATES)}; GEMM_PHASE(F.lds, F.tid, P, S, E);
            { const int nwg = (M / BM) * (GN / BM), r = nwg % F.G, nw = r == 0 ? F.G : F.G - r, wi = r == 0 ? F.bid : F.bid - r; if (wi >= 0) phase_om(F, l, wi, nw); }
        } SEAM(pb + 4);
        if (IN(pb + 5)) {
            ProbBranchT<3> P{F.ws, 512};
            TileOrder S; S.init(M / 192, D / BM, F.G, F.bid, 3);
            EpiBranchT<3> E{F.wsp<bf16_t>(WS_H), F.wsp<bf16_t>(WS_GATES)}; GEMM_PHASE3(F.lds, F.tid, P, S, E);
        } SEAM(pb + 5);
        if (IN(pb + 6)) {
            ProbSimpleT<3> P{F.wsp<bf16_t>(WS_H), F.wsp<bf16_t>(WS_WOUT), D}; TileOrder S; S.init(M / 192, D / BM, F.G, F.bid);
            EpiResidT<3> E{F.inp(I_XP), F.inp(I_XS), l == 0, F.x16(), F.x16(), F.mod(l, 0, 2)}; GEMM_PHASE3(F.lds, F.tid, P, S, E);
        } SEAM(pb + 6);
        if (IN(pb + 7)) { phase_norm2(F, l); } SEAM(pb + 7);
        if (IN(pb + 8)) {
            ProbSimple P{F.wsp<bf16_t>(WS_H), F.wsp<bf16_t>(WS_W1), D}; TileOrder S; S.init(M / BM, DFF / BM, F.G, F.bid);
            EpiRelu2 E{F.wsp<bf16_t>(WS_U)}; GEMM_PHASE(F.lds, F.tid, P, S, E);
        } SEAM(pb + 8);
        if (IN(pb + 9)) {
            if (l + 1 < DEPTH) {
                ProbSimple P{F.wsp<bf16_t>(WS_U), F.wsp<bf16_t>(WS_W2), DFF}; TileOrder S; S.init(M / BM, D / BM, F.G, F.bid);
                EpiResidT<4> E{nullptr, nullptr, 0, F.x16(), F.x16(), F.mod(l, 0, 5)}; GEMM_PHASE(F.lds, F.tid, P, S, E);
                convert_on_idle<0>(F, l + 1, (M / BM) * (D / BM));
            } else {
                ProbSimpleT<3> P{F.wsp<bf16_t>(WS_U), F.wsp<bf16_t>(WS_W2), DFF}; TileOrder S; S.init(M / 192, D / BM, F.G, F.bid);
                EpiResidT<3> E{nullptr, nullptr, 0, F.x16(), F.wsp<bf16_t>(WS_H), F.mod(l, 0, 5)}; GEMM_PHASE3(F.lds, F.tid, P, S, E);
            }
        } SEAM(pb + 9);
    }
    if (IN(N_PHASES - 1)) phase_final(F);
#undef IN
#undef SEAM
}

extern "C" void kernel_launch(void* const* d_in, const int* in_sizes, int n_in, void* d_out, int out_size, void* d_ws, size_t ws_size, hipStream_t stream) {
    static int grid = 0;
    if (grid == 0) {
        if (n_in != 31 || (size_t)out_size != O_END || ws_size < WS_END) { fprintf(stderr, "kernel_launch: unexpected shapes n_in %d out %d ws %zu\n", n_in, out_size, ws_size); grid = -1; return; }
        int dev = 0, cus = 0, per_cu = 0;
        if (hipGetDevice(&dev) != hipSuccess || hipDeviceGetAttribute(&cus, hipDeviceAttributeMultiprocessorCount, dev) != hipSuccess) { grid = -1; return; }
        if (hipFuncSetAttribute((const void*)mega_fwd, hipFuncAttributeMaxDynamicSharedMemorySize, LDS_BYTES) != hipSuccess) { fprintf(stderr, "kernel_launch: LDS attribute failed\n"); grid = -1; return; }
        if (hipOccupancyMaxActiveBlocksPerMultiprocessor(&per_cu, (const void*)mega_fwd, NTHR, LDS_BYTES) != hipSuccess || per_cu < 1) { fprintf(stderr, "kernel_launch: occupancy query says %d blocks/CU\n", per_cu); (void)hipGetLastError(); grid = -1; return; }
        grid = cus;
    }
    if (grid < 0) return;
    (void)hipMemsetAsync((char*)d_ws + WS_CTL, 0, CTL_BYTES, stream);
    Args a{};
    for (int i = 0; i < 31; ++i) a.in[i] = (const float*)d_in[i];
    a.out = (float*)d_out; a.ws = (unsigned char*)d_ws; a.ph_lo = 0; a.ph_hi = N_PHASES; a.li = 0; a.pad = 0;
    hipLaunchKernelGGL(mega_fwd, dim3(grid), dim3(NTHR), LDS_BYTES, stream, a);
}
```

```cpp
#include <hip/hip_runtime.h>
#include <cstdio>
#include <cstdint>

#define GAS __attribute__((address_space(1)))
#define LAS __attribute__((address_space(3)))
typedef unsigned short bf16_t;
typedef float f32x4 __attribute__((ext_vector_type(4)));
typedef float f32x2 __attribute__((ext_vector_type(2)));
typedef unsigned u32x4 __attribute__((ext_vector_type(4)));
typedef unsigned u32x2 __attribute__((ext_vector_type(2)));
typedef short bf16x8 __attribute__((ext_vector_type(8)));
typedef GAS unsigned gu32;
#define RLX_AGENT __ATOMIC_RELAXED, __HIP_MEMORY_SCOPE_AGENT

constexpr int D = 1024, DFF = 4096, DEPTH = 2;
constexpr int CB = 16, CS = 256, LB = 2, LS = 4096, PAST = 256;
constexpr int NCTX = CB * CS, NLAT = LB * LS, M = NCTX + NLAT;
constexpr int LT = PAST + LS;
constexpr int KROWS = NCTX + LB * LT;
constexpr int INC = 6832;
constexpr int ZN = 3840, GN = 3072, WINROWS = ZN + GN;
constexpr int HM = 4, DKM = 64, DVM = 128;
constexpr int HA = 8, QR = 384, KVR = 256, NOPE = 64, ROPA = 32, VA = 64, QKA = NOPE + ROPA;
constexpr int HD = 4, DKD = 64, DVD = 128;
constexpr float EPS = 1e-6f;
constexpr int NWAVES = 8, NTHR = 512;

constexpr size_t WS_CTL = 0, CTL_BYTES = 1u << 20;
constexpr size_t WS_SMALL = WS_CTL + CTL_BYTES;
constexpr size_t SMALL_BYTES = 256 * 1024;
constexpr size_t WS_WIN = WS_SMALL + SMALL_BYTES;
constexpr size_t WS_WQ = WS_WIN + (size_t)WINROWS * D * 2;
constexpr size_t WS_WKVG = WS_WQ + (size_t)768 * QR * 2;
constexpr size_t WS_WKV = WS_WKVG + (size_t)1024 * KVR * 2;
constexpr size_t WS_WBM = WS_WKV + (size_t)1024 * KVR * 2;
constexpr size_t WS_WBA = WS_WBM + (size_t)D * 512 * 2;
constexpr size_t WS_WBD = WS_WBA + (size_t)D * 512 * 2;
constexpr size_t WS_WOUT = WS_WBD + (size_t)D * 512 * 2;
constexpr size_t WS_W1 = WS_WOUT + (size_t)D * D * 2;
constexpr size_t WS_W2 = WS_W1 + (size_t)DFF * D * 2;
constexpr size_t WS_H = WS_W2 + (size_t)D * DFF * 2;
constexpr size_t WS_MQKVO = WS_H + (size_t)M * D * 2;
constexpr size_t WS_DQ = WS_MQKVO + (size_t)M * 1536 * 2;
constexpr size_t WS_ACQ = WS_DQ + (size_t)M * 512 * 2;
constexpr size_t WS_ACKV = WS_ACQ + (size_t)M * QR * 2;
constexpr size_t WS_DK = WS_ACKV + (size_t)M * KVR * 2;
constexpr size_t WS_DV = WS_DK + (size_t)KROWS * 512 * 2;
constexpr size_t WS_QA = WS_DV + (size_t)KROWS * 512 * 2;
constexpr int KVP = 1056;
constexpr size_t WS_KV = WS_QA + (size_t)M * 768 * 2;
constexpr size_t WS_BLK_END = WS_KV + (size_t)KROWS * KVP * 2;
constexpr size_t WS_GATES = WS_ACQ;
static_assert(WS_GATES + (size_t)M * GN * 2 <= WS_BLK_END, "gates overlay");
constexpr size_t WS_U = WS_MQKVO;
static_assert(WS_U + (size_t)M * DFF * 2 <= WS_BLK_END, "u overlay");
constexpr size_t WS_CKVC = WS_BLK_END;
constexpr size_t WS_MG = WS_CKVC + (size_t)512 * 256 * 2;
constexpr size_t WS_OA = WS_MG + (size_t)M * 16 * 4;
constexpr size_t WS_OM = WS_OA + (size_t)M * 512 * 2;
constexpr size_t WS_HF = WS_OM + (size_t)M * 512 * 2;
constexpr size_t WS_HB = WS_HF + (size_t)M * 512 * 2;
constexpr size_t WS_DEN = WS_HB + (size_t)M * 512 * 2;
constexpr int ML_NSEG = 16, ML_SEGCH = (LS / 64) / ML_NSEG;
constexpr int SLAB_F = 2048 + 64;
constexpr size_t WS_SLAB = WS_DEN + (size_t)M * 8 * 4;
constexpr size_t WS_END = WS_SLAB + (size_t)(LB * 2 * HM) * 5 * ML_NSEG * SLAB_F * 4;
static_assert(WS_END <= 268435456, "workspace must fit 256 MiB");
constexpr int CW_BAR = 4096;
constexpr int CW_QUEUE = 16384;
constexpr int CW_SSQ = 32768;
constexpr int CW_SSKV = CW_SSQ + DEPTH * M;
static_assert((size_t)(CW_SSKV + DEPTH * M) * 4 <= CTL_BYTES, "ctl");
constexpr int SM_MOD = 0;
constexpr int SM_TD = SM_MOD + DEPTH * 3 * 6 * D;
constexpr int SM_TA = SM_TD + 64 * 16 * 2;
constexpr int SM_LAM = SM_TA + 64 * 8 * 2;
static_assert((size_t)(SM_LAM + 8) * 4 <= SMALL_BYTES, "small");
constexpr size_t O_X = 0;
constexpr size_t O_CKV = (size_t)M * D;
constexpr size_t O_KROPE = O_CKV + (size_t)CB * DEPTH * CS * KVR;
constexpr size_t O_DK = O_KROPE + (size_t)CB * DEPTH * CS * ROPA;
constexpr size_t O_DV = O_DK + (size_t)CB * DEPTH * CS * 512;
constexpr size_t O_C = O_DV + (size_t)CB * DEPTH * CS * 512;
constexpr size_t O_N = O_C + (size_t)CB * DEPTH * 2 * HM * DKM * DVM;
constexpr size_t O_M = O_N + (size_t)CB * DEPTH * 2 * HM * DKM;
constexpr size_t O_END = O_M + (size_t)CB * DEPTH * 2 * HM;

constexpr int RING_BYTES = 131072;
constexpr int LDSCTL_OFF = RING_BYTES, MISC_OFF = LDSCTL_OFF + 320;
constexpr int LDS_BYTES = 147456;

__device__ __forceinline__ float bf2f(bf16_t v) { return __uint_as_float((unsigned)v << 16); }
__device__ __forceinline__ unsigned f2bf(float f) { unsigned u = __float_as_uint(f); return (u + 0x7fffu + ((u >> 16) & 1u)) >> 16; }
typedef float f32x2_ __attribute__((ext_vector_type(2))); typedef __bf16 bf16x2_ __attribute__((ext_vector_type(2)));
__device__ __forceinline__ unsigned pk2(float lo, float hi) { f32x2_ v = {lo, hi}; bf16x2_ b = __builtin_convertvector(v, bf16x2_); return __builtin_bit_cast(unsigned, b); }
__device__ __forceinline__ float lo_bf(unsigned w) { return __uint_as_float(w << 16); }
__device__ __forceinline__ float hi_bf(unsigned w) { return __uint_as_float(w & 0xffff0000u); }
__device__ __forceinline__ float sigmoidf_(float x) { return 1.f / (1.f + expf(-x)); }
__device__ __forceinline__ float logsigmoidf_(float x) { return fminf(x, 0.f) - log1pf(expf(-fabsf(x))); }
__device__ __forceinline__ float lane_xor(float v, int mask, int lane) { return __int_as_float(__builtin_amdgcn_ds_bpermute((lane ^ mask) << 2, __float_as_int(v))); }
__device__ __forceinline__ float lane_up(float v, int d, int lane) { return __int_as_float(__builtin_amdgcn_ds_bpermute((lane - d) << 2, __float_as_int(v))); }
__device__ __forceinline__ float wave_sum(float v, int lane) {
#pragma unroll
    for (int o = 1; o < 64; o <<= 1) v += lane_xor(v, o, lane);
    return v;
}
__device__ __forceinline__ int keyrow_of(int row) { if (row < NCTX) return row; const int r = row - NCTX; return NCTX + (r >> 12) * LT + PAST + (r & 4095); }
__device__ __forceinline__ int rg_of(int row) { return row < NCTX ? 0 : 1 + ((row - NCTX) >> 12); }

#define XB_TMO      128
#define XB_XCNT(j)  (256  + 64 * (j))
#define XB_XSUB(j)  (1280 + 64 * (j))
#define XB_XGEN(j)  (2304 + 64 * (j))
#define XB_TOP      3328
#define XB_TOPGEN   3392
#define XCD_BAR_WORDS 3456
#define XB_SPIN_CAP (1u << 22)
__device__ __forceinline__ unsigned xb_ld(unsigned* p)              { return __hip_atomic_load(p, __ATOMIC_RELAXED, __HIP_MEMORY_SCOPE_AGENT); }
__device__ __forceinline__ unsigned xb_add(unsigned* p, unsigned v) { return __hip_atomic_fetch_add(p, v, __ATOMIC_RELAXED, __HIP_MEMORY_SCOPE_AGENT); }
__device__ __forceinline__ unsigned xb_xcc_id() { return (unsigned)__builtin_amdgcn_s_getreg((3 << 11) | 20) & 0xFu; }
#define XB_SPIN(cond, bar) do { unsigned _sp = 0; while (cond) { __builtin_amdgcn_s_sleep(1); \
    if ((++_sp & 255u) == 0u) { if (xb_ld(&(bar)[XB_TMO])) break; if (_sp > XB_SPIN_CAP) { atomicAdd(&(bar)[XB_TMO], 1u); break; } } } } while (0)
struct XcdBarrier { unsigned* bar; unsigned x; volatile LAS unsigned* st; };
__device__ __forceinline__ XcdBarrier xcd_barrier_post(unsigned* bar, volatile LAS unsigned* st) {
    XcdBarrier b; b.bar = bar; b.x = xb_xcc_id(); b.st = st;
    if (threadIdx.x == 0) (void)xb_add(&bar[XB_XCNT(b.x)], 1u);
    return b;
}
__device__ __forceinline__ void xcd_barrier_complete(unsigned* bar, unsigned x, unsigned& nloc, unsigned& nx) {
    const unsigned G = gridDim.x * gridDim.y * gridDim.z;
    unsigned sum, cnt, mine, sp = 0u;
    for (;;) {
        sum = 0u; cnt = 0u; mine = 0u;
#pragma unroll
        for (unsigned j = 0; j < 16; ++j) { const unsigned c = xb_ld(&bar[XB_XCNT(j)]); sum += c; cnt += (c > 0u) ? 1u : 0u; mine = (j == x) ? c : mine; }
        if (sum == G) break;
        __builtin_amdgcn_s_sleep(1);
        if ((++sp & 255u) == 0u) { if (xb_ld(&bar[XB_TMO])) break; if (sp > XB_SPIN_CAP) { atomicAdd(&bar[XB_TMO], 1u); break; } }
    }
    nloc = mine > 0u ? mine : 1u; nx = cnt > 0u ? cnt : 1u;
}
__device__ __forceinline__ void xcd_barrier(const XcdBarrier& b) {
    asm volatile("s_waitcnt vmcnt(0)" ::: "memory");
    __syncthreads();
    if (threadIdx.x == 0) {
        unsigned* bar = b.bar;
        __builtin_amdgcn_s_waitcnt(0);
        unsigned nloc = b.st[0], nx = b.st[1];
        if (nloc == 0u) { xcd_barrier_complete(bar, b.x, nloc, nx); b.st[0] = nloc; b.st[1] = nx; }
        const unsigned old = xb_add(&bar[XB_XSUB(b.x)], 1u);
        const unsigned gen = old / nloc;
        if (old + 1u == (gen + 1u) * nloc) {
            __builtin_amdgcn_fence(__ATOMIC_RELEASE, "agent");
            asm volatile("s_waitcnt vmcnt(0)" ::: "memory");
            const unsigned og = xb_add(&bar[XB_TOP], 1u);
            const unsigned tg = og / nx;
            if (og + 1u == (tg + 1u) * nx) xb_add(&bar[XB_TOPGEN], 1u);
            else XB_SPIN(xb_ld(&bar[XB_TOPGEN]) == tg, bar);
            __builtin_amdgcn_fence(__ATOMIC_ACQUIRE, "agent");
            xb_add(&bar[XB_XGEN(b.x)], 1u);
            asm volatile("s_waitcnt vmcnt(0)" ::: "memory");
        } else {
            XB_SPIN(xb_ld(&bar[XB_XGEN(b.x)]) == gen, bar);
            __builtin_amdgcn_fence(__ATOMIC_ACQUIRE, "agent");
            asm volatile("s_waitcnt vmcnt(0)" ::: "memory");
        }
    }
    __syncthreads();
}

template <class T> __device__ __forceinline__ T* opaque_ptr(T* p) {
    unsigned lo = (unsigned)(uintptr_t)p, hi = (unsigned)((uintptr_t)p >> 32); asm volatile("" : "+v"(lo), "+v"(hi));
    lo = __builtin_amdgcn_readfirstlane(lo); hi = __builtin_amdgcn_readfirstlane(hi);
    return (T*)(__attribute__((address_space(1))) T*)(((uintptr_t)hi << 32) | (uintptr_t)lo);
}
__device__ __forceinline__ int opaque_int(int x) { asm volatile("" : "+v"(x)); return __builtin_amdgcn_readfirstlane(x); }
struct Args { const float* in[31]; float* out; unsigned char* ws; int ph_lo, ph_hi, li, pad; };
enum { I_XP = 0, I_XS, I_C, I_CCKV, I_CKR, I_CDK, I_CDV, I_SC, I_SN, I_SM, I_CCTX, I_WMOD, I_BMOD, I_N1G, I_WIN, I_GATEB, I_MNG, I_QNG, I_WQUP, I_KVNG, I_WKVUP,
       I_LAMBDA, I_DNG, I_WBM, I_WBA, I_WBD, I_WOUT, I_N2G, I_WFF1, I_WFF2, I_FNG };

struct Frame {
    LAS unsigned char* lds;
    int tid, lane, wave, G, bid;
    const __attribute__((address_space(4))) Args* ka;
    float* out; unsigned char* ws;
    __device__ __forceinline__ const float* inp(int i) const { return (const float*)(const __attribute__((address_space(1))) float*)ka->in[i]; }
    __device__ __forceinline__ float* smallf() const { return (float*)(ws + WS_SMALL); }
    __device__ __forceinline__ gu32* ctl() const { return (gu32*)(ws + WS_CTL); }
    template <class T> __device__ __forceinline__ T* wsp(size_t off) const { return (T*)(ws + off); }
    __device__ __forceinline__ const float* mod(int l, int rg, int chunk) const { return smallf() + SM_MOD + ((l * 3 + rg) * 6 + chunk) * D; }
    __device__ __forceinline__ bf16_t* x16() const { return (bf16_t*)(out + O_X) + (size_t)M * D; }
    __device__ __forceinline__ const float* xrow(int l, int row) const {
        if (l == 0) return row < NCTX ? inp(I_XP) + (size_t)row * D : inp(I_XS) + (size_t)(row - NCTX) * D;
        return out + O_X + (size_t)row * D;
    }
};

struct Unit { int pm, pn, aux; };
constexpr int BM = 256;
struct TileOrder {
    int nM, nN, nwg, G, c, rep;
    __device__ __forceinline__ void init(int nM_, int nN_, int G_, int c_, int rep_ = 1) { nM = nM_; nN = nN_; nwg = nM * nN; G = G_; c = c_; rep = rep_; }
    __device__ __forceinline__ bool next(int i, Unit& u) const {
        const int ti = i / rep; u.aux = i - ti * rep;
        const long L = (long)ti * G + c; if (L >= nwg) return false;
        int wgid = (int)L; { const int q = nwg / 8, r = nwg % 8, xcd = wgid % 8, off = wgid / 8; wgid = (xcd < r ? xcd * (q + 1) : r * (q + 1) + (xcd - r) * q) + off; }
        const int WGM = 8; const int nig = WGM * nN, gid = wgid / nig, fm = gid * WGM, gsz = (nM - fm) < WGM ? (nM - fm) : WGM;
        u.pm = fm + ((wgid % nig) % gsz); u.pn = (wgid % nig) / gsz; return true;
    }
};
template <int MF> struct ProbSimpleT {
    const bf16_t* A; const bf16_t* Bt; int K;
    __device__ __forceinline__ const bf16_t* a_tile(const Unit& u) const { return A + (size_t)u.pm * (64 * MF) * K; }
    __device__ __forceinline__ const bf16_t* b_tile(const Unit& u) const { return Bt + (size_t)u.pn * BM * K; }
};
typedef ProbSimpleT<4> ProbSimple;
template <int MF> struct ProbBranchT {
    const unsigned char* ws; int K;
    __device__ __forceinline__ const bf16_t* a_tile(const Unit& u) const { const size_t off = u.aux == 0 ? WS_OM : (u.aux == 1 ? WS_OA : WS_DQ); return (const bf16_t*)(ws + off) + (size_t)u.pm * (64 * MF) * K; }
    __device__ __forceinline__ const bf16_t* b_tile(const Unit& u) const { const size_t off = u.aux == 0 ? WS_WBM : (u.aux == 1 ? WS_WBA : WS_WBD); return (const bf16_t*)(ws + off) + (size_t)u.pn * BM * K; }
};
typedef f32x4 Acc[2][2][4][2];
typedef f32x4 AccH[2][4][2];

template <class Epi, class Prob, class Order>
__device__ __forceinline__ void gemm_ref(LAS unsigned char* lds, int tid_, const Prob& P, const Order& S, const Epi& E) {
    int tid = tid_; asm volatile("" : "+v"(tid));
    const int wid = tid >> 6, lane = tid & 63, wr = wid >> 2, wc = wid & 3, fr = lane & 15, fq = lane >> 4;
    LAS bf16_t* As = (LAS bf16_t*)lds; LAS bf16_t* Bs = As + 128 * 40;
    Unit u;
    for (int i = 0; S.next(i, u); ++i) {
        const bf16_t* Bg = P.b_tile(u); const int K = P.K;
#pragma unroll 1
        for (int ai = 0; ai < 2; ++ai) {
            const bf16_t* Ag = P.a_tile(u) + (size_t)ai * 128 * K;
            AccH acc;
#pragma unroll
            for (int b = 0; b < 2; ++b)
#pragma unroll
                for (int m = 0; m < 4; ++m)
#pragma unroll
                    for (int n = 0; n < 2; ++n) acc[b][m][n] = (f32x4){0.f, 0.f, 0.f, 0.f};
#pragma unroll 1
            for (int k0 = 0; k0 < K; k0 += 32) {
                __syncthreads();
                { const int r = tid >> 2, c8 = (tid & 3) * 8; *(LAS u32x4*)(As + r * 40 + c8) = *(const u32x4*)(Ag + (size_t)r * K + k0 + c8); }
#pragma unroll
                for (int j = 0; j < 2; ++j) { const int ch = tid + j * 512, r = ch >> 2, c8 = (ch & 3) * 8; *(LAS u32x4*)(Bs + r * 40 + c8) = *(const u32x4*)(Bg + (size_t)r * K + k0 + c8); }
                __syncthreads();
#pragma unroll 1
                for (int kk = 0; kk < 32; kk += 2) {
                    float a0[4], a1[4];
#pragma unroll
                    for (int m = 0; m < 4; ++m) { const unsigned w = *(const LAS unsigned*)(As + (wr * 64 + m * 16 + fr) * 40 + kk); a0[m] = lo_bf(w); a1[m] = hi_bf(w); }
#pragma unroll
                    for (int bj = 0; bj < 2; ++bj)
#pragma unroll
                        for (int n = 0; n < 2; ++n)
#pragma unroll
                            for (int e = 0; e < 4; ++e) { const unsigned w = *(const LAS unsigned*)(Bs + (bj * 128 + wc * 32 + fq * 8 + n * 4 + e) * 40 + kk);
                                const float b0 = lo_bf(w), b1 = hi_bf(w);
#pragma unroll
                                for (int m = 0; m < 4; ++m) acc[bj][m][n][e] += a0[m] * b0 + a1[m] * b1; }
                }
            }
            E(acc, ai, u, wr, wc, fr, fq);
        }
    }
    __syncthreads();
}

namespace pg8 {
constexpr int BK = 64, HALF = 128, HTB = HALF * BK * 2  , STAGE_BYTES = 8 * HTB;
__device__ __forceinline__ int lds_byte(int r, int c) { const int st = (r >> 4) * 2 + (c >> 5), rr = r & 15, cc = c & 31, ob = rr * 64 + cc * 2; return st * 1024 + (ob ^ (((ob >> 9) & 1) << 5)); }
__device__ __forceinline__ void stage_rc(int b, int& R, int& C) { const int st = b / 1024, sb = b % 1024, swz = sb ^ (((sb >> 9) & 1) << 5); R = (st >> 1) * 16 + swz / 64; C = (st & 1) * 32 + (swz % 64) / 2; }
__device__ __forceinline__ int perm32(int rho) { const int n = rho >> 4, i = rho & 15; return 8 * (i >> 2) + 4 * n + (i & 3); }

template <int MF, class Epi, class Prob, class Order>
__device__ __forceinline__ void gemm_phase(LAS unsigned char* lds, int tid_, const Prob& P, const Order& S, const Epi& E) {
    int tid = tid_; asm volatile("" : "+v"(tid));
    const int wid = __builtin_amdgcn_readfirstlane(tid >> 6), lane = tid & 63, wr = wid >> 2, wc = wid & 3, fr = lane & 15, fq = lane >> 4;
    const int K = P.K, nt = K / BK;
    unsigned voffA[2], voffB[2];
#pragma unroll
    for (int i = 0; i < 2; ++i) { int R, C; stage_rc(tid * 16 + i * 8192, R, C); const int Rb = (R & ~31) + perm32(R & 31);
        voffA[i] = (unsigned)(R * K + C) * 2u; voffB[i] = (unsigned)(Rb * K + C) * 2u; }
    const size_t kstep = (size_t)(BK * 2);
    const size_t hstepA = (size_t)(32 * MF) * K * 2, hstepB = (size_t)HALF * K * 2;
    const unsigned ldsw = (unsigned)wid * 1024u;
    const int aoff = lds_byte(wr * 16 * MF + fr, fq * 8), boff = lds_byte(wc * 32 + fr, fq * 8);
#define PG8_SA(b, h) (((b) * 2 + (h)) * HTB)
#define PG8_SB(b, h) ((4 + (b) * 2 + (h)) * HTB)
#define PG8_STAGE(bufoff, gbase, voff) do { _Pragma("unroll") for (int _i = 0; _i < 2; ++_i) \
        __builtin_amdgcn_global_load_lds((const unsigned*)((const char*)(gbase) + (voff)[_i]), (LAS unsigned*)(lds + (bufoff) + ldsw + _i * 8192), 16, 0, 0); } while (0)
#define PG8_LDA(dst, b, h) do { _Pragma("unroll") for (int m = 0; m < MF; ++m) _Pragma("unroll") for (int k = 0; k < 2; ++k) dst[m][k] = *(const LAS bf16x8*)(lds + PG8_SA(b, h) + aoff + m * 2048 + k * 1024); } while (0)
#define PG8_LDB(dst, b, h) do { _Pragma("unroll") for (int n = 0; n < 2; ++n) _Pragma("unroll") for (int k = 0; k < 2; ++k) dst[n][k] = *(const LAS bf16x8*)(lds + PG8_SB(b, h) + boff + n * 2048 + k * 1024); } while (0)
#define PG8_MMA(ai, bj, At, Bt) do { __builtin_amdgcn_s_setprio(1); _Pragma("unroll") for (int m = 0; m < MF; ++m) _Pragma("unroll") for (int n = 0; n < 2; ++n) _Pragma("unroll") for (int k = 0; k < 2; ++k) \
        acc[ai][bj][m][n] = __builtin_amdgcn_mfma_f32_16x16x32_bf16(Bt[n][k], At[m][k], acc[ai][bj][m][n], 0, 0, 0); __builtin_amdgcn_s_setprio(0); } while (0)
#define PG8_WAIT_V(n) asm volatile("s_waitcnt vmcnt(" #n ")" ::: "memory")
#define PG8_WAIT_L(n) asm volatile("s_waitcnt lgkmcnt(" #n ")" ::: "memory")
#define PG8_BAR __builtin_amdgcn_s_barrier()
#define PG8_SCHED __builtin_amdgcn_sched_barrier(0)
    Unit cur, nxt; int ui = 0;
    if (!S.next(0, cur)) return;
    Acc acc;
#pragma unroll
    for (int a = 0; a < 2; ++a)
#pragma unroll
        for (int b = 0; b < 2; ++b)
#pragma unroll
            for (int m = 0; m < 4; ++m)
#pragma unroll
                for (int n = 0; n < 2; ++n) acc[a][b][m][n] = (f32x4){0.f, 0.f, 0.f, 0.f};
    bf16x8 At[4][2], B0[2][2], B1[2][2];
    const char* cA = (const char*)P.a_tile(cur); const char* cB = (const char*)P.b_tile(cur);
    PG8_STAGE(PG8_SB(0, 0), cB, voffB); PG8_STAGE(PG8_SB(0, 1), cB + hstepB, voffB); PG8_STAGE(PG8_SA(0, 0), cA, voffA); PG8_STAGE(PG8_SA(0, 1), cA + hstepA, voffA);
    if (wr == 1) PG8_BAR;
    PG8_WAIT_V(2); PG8_BAR;
    PG8_STAGE(PG8_SB(1, 0), cB + kstep, voffB); PG8_STAGE(PG8_SA(1, 0), cA + kstep, voffA); PG8_STAGE(PG8_SB(1, 1), cB + hstepB + kstep, voffB);
    PG8_WAIT_V(6); PG8_BAR;
    for (;;) {
        const bool has_next = S.next(ui + 1, nxt);
        const char* nA = has_next ? (const char*)P.a_tile(nxt) : cA; const char* nB = has_next ? (const char*)P.b_tile(nxt) : cB;
        for (int t = 0; t < nt; t += 2) {
            const bool last = (t == nt - 2);
            const char* a1 = cA + (size_t)(t + 1) * kstep;
            const char* a2 = last ? nA : cA + (size_t)(t + 2) * kstep; const char* b2 = last ? nB : cB + (size_t)(t + 2) * kstep;
            const char* a3 = a2 + kstep; const char* b3 = b2 + kstep;
            PG8_LDB(B0, 0, 0); PG8_LDB(B1, 0, 1); PG8_SCHED; PG8_LDA(At, 0, 0); PG8_STAGE(PG8_SA(1, 1), a1 + hstepA, voffA);
            PG8_WAIT_V(8); PG8_WAIT_L(0); PG8_BAR; PG8_MMA(0, 0, At, B0); PG8_MMA(0, 1, At, B1); PG8_BAR; PG8_SCHED;
            PG8_LDA(At, 0, 1); PG8_STAGE(PG8_SB(0, 0), b2, voffB); PG8_STAGE(PG8_SB(0, 1), b2 + hstepB, voffB); PG8_STAGE(PG8_SA(0, 0), a2, voffA);
            PG8_WAIT_V(8); PG8_WAIT_L(0); PG8_BAR; PG8_MMA(1, 0, At, B0); PG8_MMA(1, 1, At, B1); PG8_BAR; PG8_SCHED;
            PG8_LDB(B0, 1, 0); PG8_LDB(B1, 1, 1); PG8_SCHED; PG8_LDA(At, 1, 0); PG8_STAGE(PG8_SA(0, 1), a2 + hstepA, voffA);
            PG8_WAIT_V(8); PG8_WAIT_L(0); PG8_BAR; PG8_MMA(0, 0, At, B0); PG8_MMA(0, 1, At, B1); PG8_BAR; PG8_SCHED;
            PG8_LDA(At, 1, 1); PG8_STAGE(PG8_SB(1, 0), b3, voffB); PG8_STAGE(PG8_SB(1, 1), b3 + hstepB, voffB); PG8_STAGE(PG8_SA(1, 0), a3, voffA);
            PG8_WAIT_V(8); PG8_WAIT_L(0); PG8_BAR; PG8_MMA(1, 0, At, B0); PG8_MMA(1, 1, At, B1); PG8_BAR; PG8_SCHED;
        }
        if (wr == 0) PG8_BAR;
        { int fr_ = fr, fq_ = fq; asm volatile("" : "+v"(fr_), "+v"(fq_));
          E(acc[0], 0, cur, wr, wc, fr_, fq_); E(acc[1], 1, cur, wr, wc, fr_, fq_); }
        if (!has_next) break;
#pragma unroll
        for (int a = 0; a < 2; ++a)
#pragma unroll
            for (int b = 0; b < 2; ++b)
#pragma unroll
                for (int m = 0; m < 4; ++m)
#pragma unroll
                    for (int n = 0; n < 2; ++n) acc[a][b][m][n] = (f32x4){0.f, 0.f, 0.f, 0.f};
        cur = nxt; cA = nA; cB = nB; ++ui;
        if (wr == 1) PG8_BAR;
    }
    PG8_WAIT_V(0);
    PG8_BAR;
#undef PG8_SA
#undef PG8_SB
#undef PG8_STAGE
#undef PG8_LDA
#undef PG8_LDB
#undef PG8_MMA
#undef PG8_WAIT_V
#undef PG8_WAIT_L
#undef PG8_BAR
#undef PG8_SCHED
}
}

__device__ __forceinline__ u32x4 pack8(const f32x4 v0, const f32x4 v1) { u32x4 w; w.x = pk2(v0[0], v0[1]); w.y = pk2(v0[2], v0[3]); w.z = pk2(v1[0], v1[1]); w.w = pk2(v1[2], v1[3]); return w; }
__device__ __forceinline__ void rope4(f32x4& v0, f32x4& v1, const float* tab) {
    const f32x4 t0 = *(const f32x4*)tab, t1 = *(const f32x4*)(tab + 4);
    const float a0 = v0[0] * t0[0] - v0[1] * t0[1], b0 = v0[0] * t0[1] + v0[1] * t0[0];
    const float a1 = v0[2] * t0[2] - v0[3] * t0[3], b1 = v0[2] * t0[3] + v0[3] * t0[2];
    const float a2 = v1[0] * t1[0] - v1[1] * t1[1], b2 = v1[0] * t1[1] + v1[1] * t1[0];
    const float a3 = v1[2] * t1[2] - v1[3] * t1[3], b3 = v1[2] * t1[3] + v1[3] * t1[2];
    v0 = (f32x4){a0, b0, a1, b1}; v1 = (f32x4){a2, b2, a3, b3};
}
__device__ __forceinline__ void rope4r(f32x4& v0, f32x4& v1, const f32x4 t0, const f32x4 t1) {
    const float a0 = v0[0] * t0[0] - v0[1] * t0[1], b0 = v0[0] * t0[1] + v0[1] * t0[0];
    const float a1 = v0[2] * t0[2] - v0[3] * t0[3], b1 = v0[2] * t0[3] + v0[3] * t0[2];
    const float a2 = v1[0] * t1[0] - v1[1] * t1[1], b2 = v1[0] * t1[1] + v1[1] * t1[0];
    const float a3 = v1[2] * t1[2] - v1[3] * t1[3], b3 = v1[2] * t1[3] + v1[3] * t1[2];
    v0 = (f32x4){a0, b0, a1, b1}; v1 = (f32x4){a2, b2, a3, b3};
}
template <int NPH> __device__ __forceinline__ const float* rope_tab(const float* T, int t, int i0) {
    const int pos = (i0 < NPH) ? (t >> 6) : (t & 63); return T + (pos * NPH + (i0 & (NPH - 1))) * 2;
}
#define EPI_LOOP_BEGIN \
    _Pragma("unroll") for (int m = 0; m < MF_; ++m) { const int row = u.pm * (64 * MF_) + ai * (32 * MF_) + wr * (16 * MF_) + m * 16 + fr; \
    _Pragma("unroll") for (int bj = 0; bj < 2; ++bj) { const int ct = bj * 128 + wc * 32 + 8 * fq; f32x4 v0 = acc[bj][m][0], v1 = acc[bj][m][1];
#define EPI_LOOP_END } asm volatile("" ::: "memory"); }

struct EpiZ {
    static constexpr int MF_ = 4;
    int l; unsigned char* ws; float* out; const float* gate_b;
    __device__ __forceinline__ void operator()(const AccH& acc, int ai, const Unit& u, int wr, int wc, int fr, int fq) const {
        const int pn = u.pn; const bool lat = u.pm >= NCTX / BM;
        bf16_t* const mqkvo = (bf16_t*)(ws + WS_MQKVO); bf16_t* const dq = (bf16_t*)(ws + WS_DQ); bf16_t* const dk = (bf16_t*)(ws + WS_DK); bf16_t* const dv = (bf16_t*)(ws + WS_DV);
        bf16_t* const acq = (bf16_t*)(ws + WS_ACQ); bf16_t* const ackv = (bf16_t*)(ws + WS_ACKV); bf16_t* const kr = (bf16_t*)(ws + WS_KV) + 1024; float* const mg = (float*)(ws + WS_MG);
        float* const ssq = (float*)(ws + WS_CTL) + CW_SSQ + l * M; float* const sskv = (float*)(ws + WS_CTL) + CW_SSKV + l * M;
        const float* const Td = (const float*)(ws + WS_SMALL) + SM_TD; const float* const Ta = (const float*)(ws + WS_SMALL) + SM_TA;
        EPI_LOOP_BEGIN
            if (pn < 6) { *(u32x4*)(mqkvo + (size_t)row * 1536 + pn * 256 + ct) = pack8(v0, v1); }
            else if (pn < 8) {
                if (lat) rope4(v0, v1, rope_tab<16>(Td, (row - NCTX) & 4095, (ct & 63) >> 1));
                *(u32x4*)(dq + (size_t)row * 512 + (pn - 6) * 256 + ct) = pack8(v0, v1);
            } else if (pn < 10) {
                const int c = (pn - 8) * 256 + ct;
                if (lat) rope4(v0, v1, rope_tab<16>(Td, (row - NCTX) & 4095, (ct & 63) >> 1));
                else { float* o = out + O_DK + ((size_t)((row >> 8) * DEPTH + l) * CS + (row & 255)) * 512 + (c & ~63) + ((c & 63) >> 1);
                    *(f32x4*)o = (f32x4){v0[0], v0[2], v1[0], v1[2]}; *(f32x4*)(o + 32) = (f32x4){v0[1], v0[3], v1[1], v1[3]}; }
                *(u32x4*)(dk + (size_t)keyrow_of(row) * 512 + c) = pack8(v0, v1);
            } else if (pn < 12) {
                const int c = (pn - 10) * 256 + ct;
                if (!lat) { float* o = out + O_DV + ((size_t)((row >> 8) * DEPTH + l) * CS + (row & 255)) * 512 + c; *(f32x4*)o = v0; *(f32x4*)(o + 4) = v1; }
                *(u32x4*)(dv + (size_t)keyrow_of(row) * 512 + c) = pack8(v0, v1);
            } else if (pn == 12 || (pn == 13 && bj == 0) || pn == 14) {
                float s = (v0[0] * v0[0] + v0[1] * v0[1]) + (v0[2] * v0[2] + v0[3] * v0[3]) + (v1[0] * v1[0] + v1[1] * v1[1]) + (v1[2] * v1[2] + v1[3] * v1[3]);
                { const int ln_ = fq * 16 + fr; s += lane_xor(s, 16, ln_); s += lane_xor(s, 32, ln_); }
                if (pn == 14) { *(u32x4*)(ackv + (size_t)row * KVR + ct) = pack8(v0, v1); if (fq == 0) atomicAdd(sskv + row, s); }
                else { *(u32x4*)(acq + (size_t)row * QR + (pn - 12) * 256 + ct) = pack8(v0, v1); if (fq == 0) atomicAdd(ssq + row, s); }
            } else if (pn == 13) {
                if (ct < 160) {
                    const int c = ct - 128;
                    if (lat) rope4(v0, v1, rope_tab<8>(Ta, (row - NCTX) & 4095, c >> 1));
                    else { float* o = out + O_KROPE + ((size_t)((row >> 8) * DEPTH + l) * CS + (row & 255)) * ROPA + (c >> 1);
                        *(f32x4*)o = (f32x4){v0[0], v0[2], v1[0], v1[2]}; *(f32x4*)(o + 16) = (f32x4){v0[1], v0[3], v1[1], v1[3]}; }
                    *(u32x4*)(kr + (size_t)keyrow_of(row) * KVP + c) = pack8(v0, v1);
                } else if (ct < 176) {
                    const int c = ct - 160; const float* gb = gate_b + l * 16 + c; float* o = mg + (size_t)row * 16 + c;
                    *(f32x4*)o = v0 + *(const f32x4*)gb; *(f32x4*)(o + 4) = v1 + *(const f32x4*)(gb + 4);
                }
            }
        EPI_LOOP_END
    }
};
struct EpiQ {
    static constexpr int MF_ = 4;
    bf16_t* qa; const float* ssq; const float* Ta;
    __device__ __forceinline__ void operator()(const AccH& acc, int ai, const Unit& u, int wr, int wc, int fr, int fq) const {
        const bool lat = u.pm >= NCTX / BM;
        float rs_[4];
#pragma unroll
        for (int m = 0; m < 4; ++m) rs_[m] = ssq[u.pm * BM + ai * 128 + wr * 64 + m * 16 + fr];
        f32x4 ta_[4][2], tb_[4][2];
        if (lat) {
#pragma unroll
            for (int m = 0; m < 4; ++m)
#pragma unroll
                for (int bj = 0; bj < 2; ++bj) { const int row = u.pm * BM + ai * 128 + wr * 64 + m * 16 + fr, j = (u.pn * 256 + bj * 128 + wc * 32 + 8 * fq) % QKA;
                    const float* tp = rope_tab<8>(Ta, (row - NCTX) & 4095, (j >= NOPE ? j - NOPE : 0) >> 1); ta_[m][bj] = *(const f32x4*)tp; tb_[m][bj] = *(const f32x4*)(tp + 4); } }
        EPI_LOOP_BEGIN
            const int c = u.pn * 256 + ct; const float r = rsqrtf(rs_[m] * (1.f / QR) + EPS);
            v0 = v0 * r; v1 = v1 * r;
            const int j = c % QKA;
            if (lat && j >= NOPE) rope4r(v0, v1, ta_[m][bj], tb_[m][bj]);
            *(u32x4*)(qa + (size_t)row * 768 + c) = pack8(v0, v1);
        EPI_LOOP_END
    }
};
struct EpiKV {
    static constexpr int MF_ = 4;
    bf16_t* kv; const float* sskv; int cached;
    __device__ __forceinline__ void operator()(const AccH& acc, int ai, const Unit& u, int wr, int wc, int fr, int fq) const {
        float rs_[4] = {0.f, 0.f, 0.f, 0.f};
        if (!cached) {
#pragma unroll
            for (int m = 0; m < 4; ++m) rs_[m] = sskv[u.pm * BM + ai * 128 + wr * 64 + m * 16 + fr]; }
        EPI_LOOP_BEGIN
            const int c = u.pn * 256 + ct; float r = 1.f; int kr_;
            if (cached) { kr_ = NCTX + (row >> 8) * LT + (row & 255); }
            else { r = rsqrtf(rs_[m] * (1.f / KVR) + EPS); kr_ = keyrow_of(row); }
            v0 = v0 * r; v1 = v1 * r;
            *(u32x4*)(kv + (size_t)kr_ * KVP + c) = pack8(v0, v1);
        EPI_LOOP_END
    }
};
struct EpiGate {
    static constexpr int MF_ = 4;
    bf16_t* gates;
    __device__ __forceinline__ void operator()(const AccH& acc, int ai, const Unit& u, int wr, int wc, int fr, int fq) const {
        EPI_LOOP_BEGIN
#pragma unroll
            for (int e = 0; e < 4; ++e) { v0[e] = __builtin_amdgcn_rcpf(1.f + __builtin_amdgcn_exp2f(-1.4426950408889634f * v0[e])); v1[e] = __builtin_amdgcn_rcpf(1.f + __builtin_amdgcn_exp2f(-1.4426950408889634f * v1[e])); }
            *(u32x4*)(gates + (size_t)row * GN + u.pn * 256 + ct) = pack8(v0, v1);
        EPI_LOOP_END
    }
};
template <int MF> struct EpiBranchT {
    static constexpr int MF_ = MF;
    bf16_t* y; const bf16_t* gates;
    __device__ __forceinline__ void operator()(const AccH& acc, int ai, const Unit& u, int wr, int wc, int fr, int fq) const {
        if constexpr (MF == 3) {
            const int rb = u.pm * 192 + ai * 96 + wr * 48 + fr, cb = u.pn * 256 + wc * 32 + 8 * fq;
            u32x4 gw[3][2], yw[3][2];
#pragma unroll
            for (int m = 0; m < 3; ++m)
#pragma unroll
                for (int bj = 0; bj < 2; ++bj) { const size_t row = (size_t)(rb + m * 16); const int c = cb + bj * 128;
                    gw[m][bj] = *(const u32x4*)(gates + row * GN + u.aux * 1024 + c);
                    if (u.aux != 0) yw[m][bj] = *(const u32x4*)(y + row * D + c); else yw[m][bj] = (u32x4){0u, 0u, 0u, 0u}; }
#pragma unroll
            for (int m = 0; m < 3; ++m)
#pragma unroll
                for (int bj = 0; bj < 2; ++bj) { const size_t row = (size_t)(rb + m * 16); const int c = cb + bj * 128; const u32x4 g = gw[m][bj], o = yw[m][bj];
                    f32x4 p0 = (f32x4){lo_bf(o.x), hi_bf(o.x), lo_bf(o.y), hi_bf(o.y)}, p1 = (f32x4){lo_bf(o.z), hi_bf(o.z), lo_bf(o.w), hi_bf(o.w)};
                    p0 += acc[bj][m][0] * (f32x4){lo_bf(g.x), hi_bf(g.x), lo_bf(g.y), hi_bf(g.y)}; p1 += acc[bj][m][1] * (f32x4){lo_bf(g.z), hi_bf(g.z), lo_bf(g.w), hi_bf(g.w)};
                    *(u32x4*)(y + row * D + c) = pack8(p0, p1); }
            asm volatile("" ::: "memory");
            return;
        }
        EPI_LOOP_BEGIN
            const int c = u.pn * 256 + ct; const u32x4 g = *(const u32x4*)(gates + (size_t)row * GN + u.aux * 1024 + c);
            u32x4* yp = (u32x4*)(y + (size_t)row * D + c);
            f32x4 p0 = (f32x4){0.f, 0.f, 0.f, 0.f}, p1 = p0;
            if (u.aux != 0) { const u32x4 o = *yp; p0 = (f32x4){lo_bf(o.x), hi_bf(o.x), lo_bf(o.y), hi_bf(o.y)}; p1 = (f32x4){lo_bf(o.z), hi_bf(o.z), lo_bf(o.w), hi_bf(o.w)}; }
            p0 += v0 * (f32x4){lo_bf(g.x), hi_bf(g.x), lo_bf(g.y), hi_bf(g.y)}; p1 += v1 * (f32x4){lo_bf(g.z), hi_bf(g.z), lo_bf(g.w), hi_bf(g.w)};
            *yp = pack8(p0, p1);
        EPI_LOOP_END
    }
};
template <int MF> struct EpiResidT {
    static constexpr int MF_ = MF;
    const float* xp; const float* xs; int l0; const bf16_t* X16; bf16_t* Xo; const float* gmod;
    __device__ __forceinline__ void operator()(const AccH& acc, int ai, const Unit& u, int wr, int wc, int fr, int fq) const {
        if constexpr (MF == 3) { if (!l0) {
            const int rb = u.pm * 192 + ai * 96 + wr * 48 + fr, cb = u.pn * 256 + wc * 32 + 8 * fq;
            u32x4 xw[3][2]; f32x4 ga[3][2], gb[3][2];
#pragma unroll
            for (int m = 0; m < 3; ++m)
#pragma unroll
                for (int bj = 0; bj < 2; ++bj) { const int row = rb + m * 16, c = cb + bj * 128; const float* g = gmod + rg_of(row) * 6 * D + c;
                    xw[m][bj] = *(const u32x4*)(X16 + (size_t)row * D + c); ga[m][bj] = *(const f32x4*)g; gb[m][bj] = *(const f32x4*)(g + 4); }
#pragma unroll
            for (int m = 0; m < 3; ++m)
#pragma unroll
                for (int bj = 0; bj < 2; ++bj) { const int row = rb + m * 16, c = cb + bj * 128; const u32x4 w = xw[m][bj];
                    const f32x4 x0 = (f32x4){lo_bf(w.x), hi_bf(w.x), lo_bf(w.y), hi_bf(w.y)}, x1 = (f32x4){lo_bf(w.z), hi_bf(w.z), lo_bf(w.w), hi_bf(w.w)};
                    *(u32x4*)(Xo + (size_t)row * D + c) = pack8(x0 + ga[m][bj] * acc[bj][m][0], x1 + gb[m][bj] * acc[bj][m][1]); }
            asm volatile("" ::: "memory");
            return;
        } else {
            const int rb = u.pm * 192 + ai * 96 + wr * 48 + fr, cb = u.pn * 256 + wc * 32 + 8 * fq;
            f32x4 xa[3][2], xb[3][2], ga[3][2], gb[3][2];
#pragma unroll
            for (int m = 0; m < 3; ++m)
#pragma unroll
                for (int bj = 0; bj < 2; ++bj) { const int row = rb + m * 16, c = cb + bj * 128; const float* g = gmod + rg_of(row) * 6 * D + c;
                    const float* xi = (row < NCTX ? xp + (size_t)row * D : xs + (size_t)(row - NCTX) * D) + c;
                    xa[m][bj] = *(const f32x4*)xi; xb[m][bj] = *(const f32x4*)(xi + 4); ga[m][bj] = *(const f32x4*)g; gb[m][bj] = *(const f32x4*)(g + 4); }
#pragma unroll
            for (int m = 0; m < 3; ++m)
#pragma unroll
                for (int bj = 0; bj < 2; ++bj) { const int row = rb + m * 16, c = cb + bj * 128;
                    *(u32x4*)(Xo + (size_t)row * D + c) = pack8(xa[m][bj] + ga[m][bj] * acc[bj][m][0], xb[m][bj] + gb[m][bj] * acc[bj][m][1]); }
            asm volatile("" ::: "memory");
            return;
        } }
        if constexpr (MF == 4) { if (!l0) {
            const int rb = u.pm * 256 + ai * 128 + wr * 64 + fr, cb = u.pn * 256 + wc * 32 + 8 * fq;
#pragma unroll
            for (int m0 = 0; m0 < 4; m0 += 2) { u32x4 xw[2][2]; f32x4 ga[2][2], gb[2][2];
#pragma unroll
                for (int mi = 0; mi < 2; ++mi)
#pragma unroll
                    for (int bj = 0; bj < 2; ++bj) { const int row = rb + (m0 + mi) * 16, c = cb + bj * 128; const float* g = gmod + rg_of(row) * 6 * D + c;
                        xw[mi][bj] = *(const u32x4*)(X16 + (size_t)row * D + c); ga[mi][bj] = *(const f32x4*)g; gb[mi][bj] = *(const f32x4*)(g + 4); }
#pragma unroll
                for (int mi = 0; mi < 2; ++mi)
#pragma unroll
                    for (int bj = 0; bj < 2; ++bj) { const int row = rb + (m0 + mi) * 16, c = cb + bj * 128; const u32x4 w = xw[mi][bj];
                        const f32x4 x0 = (f32x4){lo_bf(w.x), hi_bf(w.x), lo_bf(w.y), hi_bf(w.y)}, x1 = (f32x4){lo_bf(w.z), hi_bf(w.z), lo_bf(w.w), hi_bf(w.w)};
                        *(u32x4*)(Xo + (size_t)row * D + c) = pack8(x0 + ga[mi][bj] * acc[bj][m0 + mi][0], x1 + gb[mi][bj] * acc[bj][m0 + mi][1]); }
                asm volatile("" ::: "memory"); }
            return;
        } }
        EPI_LOOP_BEGIN
            const int c = u.pn * 256 + ct; const float* g = gmod + rg_of(row) * 6 * D + c;
            f32x4 x0, x1;
            if (l0) { const float* xi = row < NCTX ? xp + (size_t)row * D : xs + (size_t)(row - NCTX) * D; x0 = *(const f32x4*)(xi + c); x1 = *(const f32x4*)(xi + c + 4); }
            else { const u32x4 w = *(const u32x4*)(X16 + (size_t)row * D + c); x0 = (f32x4){lo_bf(w.x), hi_bf(w.x), lo_bf(w.y), hi_bf(w.y)}; x1 = (f32x4){lo_bf(w.z), hi_bf(w.z), lo_bf(w.w), hi_bf(w.w)}; }
            *(u32x4*)(Xo + (size_t)row * D + c) = pack8(x0 + *(const f32x4*)g * v0, x1 + *(const f32x4*)(g + 4) * v1);
        EPI_LOOP_END
    }
};
struct EpiRelu2 {
    static constexpr int MF_ = 4;
    bf16_t* U;
    __device__ __forceinline__ void operator()(const AccH& acc, int ai, const Unit& u, int wr, int wc, int fr, int fq) const {
        EPI_LOOP_BEGIN
#pragma unroll
            for (int e = 0; e < 4; ++e) { const float a = fmaxf(v0[e], 0.f), b = fmaxf(v1[e], 0.f); v0[e] = a * a; v1[e] = b * b; }
            *(u32x4*)(U + (size_t)row * DFF + u.pn * 256 + ct) = pack8(v0, v1);
        EPI_LOOP_END
    }
};

__device__ __forceinline__ int zcol_of(int n, float& cs) {
    cs = 1.f;
    if (n < 1536) { if (n < 256) cs = 0.125f; return n; }
    if (n < 1552) return 3328 + 160 + (n - 1536);
    if (n < 1936) return 3072 + (n - 1552);
    if (n < 2192) return 3584 + (n - 1936);
    if (n < 2224) { const int a = n - 2192; return 3328 + 128 + 2 * (a & 15) + (a >> 4); }
    if (n < 2736) { const int a = n - 2224, j = a & 63; return 1536 + (a & ~63) + 2 * (j & 31) + (j >> 5); }
    if (n < 3248) { const int a = n - 2736, j = a & 63; return 2048 + (a & ~63) + 2 * (j & 31) + (j >> 5); }
    if (n < 3760) return 2560 + (n - 3248);
    return ZN + (n - 3760);
}
__device__ __forceinline__ int qcol_of(int n) { const int h = n / QKA, j = n - h * QKA; if (j < NOPE) return n; const int a = j - NOPE; return h * QKA + NOPE + 2 * (a & 15) + (a >> 4); }
template <int MODE>
__device__ __forceinline__ void transpose_item(const float* W, int K, int N, bf16_t* WT, const float* kscale, LAS float* scr, int item, int lane) {
    const int nblk = (N + 31) / 32, kb = item / nblk, nb = item - kb * nblk, k0 = 64 * kb, n0 = 32 * nb;
    const int nl = n0 + (lane & 31); const bool nok = nl < N;
    float tmp[32];
#pragma unroll
    for (int i = 0; i < 32; ++i) { const int kk = 2 * i + (lane >> 5); tmp[i] = nok ? W[(size_t)(k0 + kk) * N + nl] : 0.f; }
#pragma unroll
    for (int i = 0; i < 32; ++i) { const int kk = 2 * i + (lane >> 5); scr[kk * 33 + (lane & 31)] = tmp[i]; }
    asm volatile("s_waitcnt lgkmcnt(0)" ::: "memory");
    const int c = lane & 7;
    float ks[8];
#pragma unroll
    for (int e = 0; e < 8; ++e) ks[e] = kscale ? kscale[k0 + 8 * c + e] : 1.f;
#pragma unroll
    for (int j = 0; j < 4; ++j) { const int n = (lane >> 3) + 8 * j; const LAS float* s = scr + (8 * c) * 33 + n;
        if (n0 + n < N) { float cs = 1.f; int dr;
            if (MODE == 1) dr = zcol_of(n0 + n, cs); else if (MODE == 2) dr = qcol_of(n0 + n); else dr = n0 + n;
            u32x4 o; o.x = pk2(s[0 * 33] * ks[0] * cs, s[1 * 33] * ks[1] * cs); o.y = pk2(s[2 * 33] * ks[2] * cs, s[3 * 33] * ks[3] * cs);
            o.z = pk2(s[4 * 33] * ks[4] * cs, s[5 * 33] * ks[5] * cs); o.w = pk2(s[6 * 33] * ks[6] * cs, s[7 * 33] * ks[7] * cs);
            *(u32x4*)(WT + (size_t)dr * K + k0 + 8 * c) = o; } }
    asm volatile("s_waitcnt lgkmcnt(0)" ::: "memory");
}
__device__ __forceinline__ void rmsmod_row(const float* xrow, const float* g, const float* sc, const float* sh, bf16_t* orow, int lane) {
    f32x4 v[4]; float s = 0.f;
#pragma unroll
    for (int j = 0; j < 4; ++j) { v[j] = *(const f32x4*)(xrow + 4 * lane + 256 * j); s += (v[j][0] * v[j][0] + v[j][1] * v[j][1]) + (v[j][2] * v[j][2] + v[j][3] * v[j][3]); }
    const float r = rsqrtf(wave_sum(s, lane) * (1.f / D) + EPS);
#pragma unroll
    for (int j = 0; j < 4; ++j) { const int c = 4 * lane + 256 * j; const f32x4 gg = *(const f32x4*)(g + c), a = *(const f32x4*)(sc + c), b = *(const f32x4*)(sh + c);
        const f32x4 h = v[j] * r * gg * (a + 1.f) + b; u32x2 w; w.x = pk2(h[0], h[1]); w.y = pk2(h[2], h[3]); *(u32x2*)(orow + c) = w; }
}

__device__ __forceinline__ void rmsmod_row16(const bf16_t* xrow, const float* g, const float* sc, const float* sh, bf16_t* orow, int lane) {
    f32x4 v[4]; float s = 0.f;
#pragma unroll
    for (int j = 0; j < 4; ++j) { const u32x2 w = *(const u32x2*)(xrow + 4 * lane + 256 * j); v[j] = (f32x4){lo_bf(w.x), hi_bf(w.x), lo_bf(w.y), hi_bf(w.y)}; s += (v[j][0] * v[j][0] + v[j][1] * v[j][1]) + (v[j][2] * v[j][2] + v[j][3] * v[j][3]); }
    const float r = rsqrtf(wave_sum(s, lane) * (1.f / D) + EPS);
#pragma unroll
    for (int j = 0; j < 4; ++j) { const int c = 4 * lane + 256 * j; const f32x4 gg = *(const f32x4*)(g + c), a = *(const f32x4*)(sc + c), b = *(const f32x4*)(sh + c);
        const f32x4 h = v[j] * r * gg * (a + 1.f) + b; u32x2 w; w.x = pk2(h[0], h[1]); w.y = pk2(h[2], h[3]); *(u32x2*)(orow + c) = w; }
}

template <bool F32IN, int NB>
__device__ __forceinline__ void rmsmod_rows(Frame& F, int l, int row0, int stride, const float* g, int ch_sc, int ch_sh) {
    const int lane = F.lane; bf16_t* H = F.wsp<bf16_t>(WS_H);
    f32x4 v[NB][4], a[NB][4], b[NB][4], gg[4];
#pragma unroll
    for (int i = 0; i < NB; ++i) { const int row = min(row0 + i * stride, M - 1), rg = rg_of(row);
        if constexpr (F32IN) { const float* x = F.xrow(0, row);
#pragma unroll
            for (int j = 0; j < 4; ++j) v[i][j] = *(const f32x4*)(x + 4 * lane + 256 * j); }
        else { const bf16_t* x = F.x16() + (size_t)row * D;
#pragma unroll
            for (int j = 0; j < 4; ++j) { const u32x2 w = *(const u32x2*)(x + 4 * lane + 256 * j); v[i][j] = (f32x4){lo_bf(w.x), hi_bf(w.x), lo_bf(w.y), hi_bf(w.y)}; } }
        const float* sc = F.mod(l, rg, ch_sc); const float* sh = F.mod(l, rg, ch_sh);
#pragma unroll
        for (int j = 0; j < 4; ++j) { a[i][j] = *(const f32x4*)(sc + 4 * lane + 256 * j); b[i][j] = *(const f32x4*)(sh + 4 * lane + 256 * j); } }
#pragma unroll
    for (int j = 0; j < 4; ++j) gg[j] = *(const f32x4*)(g + 4 * lane + 256 * j);
#pragma unroll
    for (int i = 0; i < NB; ++i) { const int row = row0 + i * stride; float s = 0.f;
#pragma unroll
        for (int j = 0; j < 4; ++j) s += (v[i][j][0] * v[i][j][0] + v[i][j][1] * v[i][j][1]) + (v[i][j][2] * v[i][j][2] + v[i][j][3] * v[i][j][3]);
        const float r = rsqrtf(wave_sum(s, lane) * (1.f / D) + EPS);
        if (row < M) {
#pragma unroll
            for (int j = 0; j < 4; ++j) { const f32x4 h = v[i][j] * r * gg[j] * (a[i][j] + 1.f) + b[i][j]; u32x2 w; w.x = pk2(h[0], h[1]); w.y = pk2(h[2], h[3]); *(u32x2*)(H + (size_t)row * D + 4 * lane + 256 * j) = w; } } }
}

__device__ __forceinline__ void phase_mod(Frame& F) {
    LAS float* sl = (LAS float*)F.lds;
    for (int i = F.tid; i < 3 * D; i += NTHR) { const int r = i / D, k = i - r * D; const float cv = r == 0 ? F.inp(I_CCTX)[k] : F.inp(I_C)[(r - 1) * D + k]; sl[i] = cv * sigmoidf_(cv); }
    __syncthreads();
    LAS float* red = sl + 3 * D;
    for (int item = F.bid; item < DEPTH * 96; item += F.G) {
        const int l = item / 96, n0 = (item % 96) * 64; const float* W = F.inp(I_WMOD) + (size_t)l * D * 6 * D + n0 + F.lane;
        float a0 = 0.f, a1 = 0.f, a2 = 0.f;
#pragma unroll 8
        for (int kk = 0; kk < 128; ++kk) { const int k = F.wave * 128 + kk; const float w = W[(size_t)k * 6 * D]; a0 += sl[k] * w; a1 += sl[D + k] * w; a2 += sl[2 * D + k] * w; }
        red[(F.wave * 3 + 0) * 64 + F.lane] = a0; red[(F.wave * 3 + 1) * 64 + F.lane] = a1; red[(F.wave * 3 + 2) * 64 + F.lane] = a2;
        __syncthreads();
        if (F.tid < 192) { const int r = F.tid >> 6, c = F.tid & 63; float s = 0.f;
#pragma unroll
            for (int w = 0; w < 8; ++w) s += red[(w * 3 + r) * 64 + c];
            const int n = n0 + c; F.smallf()[SM_MOD + (l * 3 + r) * 6 * D + n] = s + F.inp(I_BMOD)[l * 6 * D + n]; }
        __syncthreads();
    }
    if (F.bid == F.G - 1) {
        for (int i = F.tid; i < 64 * 16; i += NTHR) { const int p = i >> 4, j = i & 15; double inv = 1.0; for (int q = 0; q < j; ++q) inv *= 0.56234132519034908;
            float s, c; sincosf((float)((double)p * inv), &s, &c); F.smallf()[SM_TD + i * 2] = c; F.smallf()[SM_TD + i * 2 + 1] = s; }
        for (int i = F.tid; i < 64 * 8; i += NTHR) { const int p = i >> 3, j = i & 7; double inv = 1.0; for (int q = 0; q < j; ++q) inv *= 0.31622776601683794;
            float s, c; sincosf((float)((double)p * inv), &s, &c); F.smallf()[SM_TA + i * 2] = c; F.smallf()[SM_TA + i * 2 + 1] = s; }
        if (F.wave < DEPTH) { const int l = F.wave; const float* lv = F.inp(I_LAMBDA) + l * 4 * DKD;
            const float s1 = wave_sum(lv[F.lane] * lv[64 + F.lane], F.lane), s2 = wave_sum(lv[128 + F.lane] * lv[192 + F.lane], F.lane);
            const float li = 0.8f - 0.6f * expf(-0.3f * (float)l);
            if (F.lane == 0) { F.smallf()[SM_LAM + l * 2] = expf(s1) - expf(s2) + li; F.smallf()[SM_LAM + l * 2 + 1] = li; } }
    }
}

template <int SET>
__device__ __forceinline__ void convert_set(Frame& F, int l, int gw, int NGW) {
    LAS float* scr = (LAS float*)(F.lds + F.wave * 16384);
    constexpr int I_IN = (D / 64) * ((INC + 31) / 32), I_Q = (QR / 64) * (768 / 32), I_KV = (KVR / 64) * (1024 / 32), I_BR = (512 / 64) * (D / 32),
                  I_OUT = (D / 64) * (D / 32), I_F1 = (D / 64) * (DFF / 32), I_F2 = (DFF / 64) * (D / 32);
    if (SET == 0) {
        constexpr int NITEMS = I_IN + I_Q + 2 * I_KV;
        for (int it = gw; it < NITEMS; it += NGW) {
            int r = it;
            if (r < I_IN) { transpose_item<1>(F.inp(I_WIN) + (size_t)l * D * INC, D, INC, F.wsp<bf16_t>(WS_WIN), nullptr, scr, r, F.lane); continue; } r -= I_IN;
            if (r < I_Q) { transpose_item<2>(F.inp(I_WQUP) + (size_t)l * QR * 768, QR, 768, F.wsp<bf16_t>(WS_WQ), F.inp(I_QNG) + l * QR, scr, r, F.lane); continue; } r -= I_Q;
            if (r < I_KV) { transpose_item<0>(F.inp(I_WKVUP) + (size_t)l * KVR * 1024, KVR, 1024, F.wsp<bf16_t>(WS_WKVG), F.inp(I_KVNG) + l * KVR, scr, r, F.lane); continue; } r -= I_KV;
            transpose_item<0>(F.inp(I_WKVUP) + (size_t)l * KVR * 1024, KVR, 1024, F.wsp<bf16_t>(WS_WKV), nullptr, scr, r, F.lane);
        }
    } else if (SET == 1) {
        constexpr int NITEMS = 3 * I_BR + I_OUT;
        for (int it = gw; it < NITEMS; it += NGW) {
            int r = it;
            if (r < I_BR) { transpose_item<0>(F.inp(I_WBM) + (size_t)l * 512 * D, 512, D, F.wsp<bf16_t>(WS_WBM), nullptr, scr, r, F.lane); continue; } r -= I_BR;
            if (r < I_BR) { transpose_item<0>(F.inp(I_WBA) + (size_t)l * 512 * D, 512, D, F.wsp<bf16_t>(WS_WBA), nullptr, scr, r, F.lane); continue; } r -= I_BR;
            if (r < I_BR) { transpose_item<0>(F.inp(I_WBD) + (size_t)l * 512 * D, 512, D, F.wsp<bf16_t>(WS_WBD), nullptr, scr, r, F.lane); continue; } r -= I_BR;
            transpose_item<0>(F.inp(I_WOUT) + (size_t)l * D * D, D, D, F.wsp<bf16_t>(WS_WOUT), nullptr, scr, r, F.lane);
        }
    } else if (SET == 2) {
        for (int it = gw; it < I_F1; it += NGW) transpose_item<0>(F.inp(I_WFF1) + (size_t)l * D * DFF, D, DFF, F.wsp<bf16_t>(WS_W1), nullptr, scr, it, F.lane);
    } else {
        for (int it = gw; it < I_F2; it += NGW) transpose_item<0>(F.inp(I_WFF2) + (size_t)l * DFF * D, DFF, D, F.wsp<bf16_t>(WS_W2), nullptr, scr, it, F.lane);
    }
}
template <int SET>
__device__ __forceinline__ void convert_on_idle(Frame& F, int l, int nwg) {
    const int r = nwg % F.G, nw = r == 0 ? F.G : F.G - r, wi = r == 0 ? F.bid : F.bid - r;
    if (wi >= 0) convert_set<SET>(F, l, wi * NWAVES + F.wave, nw * NWAVES);
}
constexpr int LATE_ITEMS = 3 * (512 / 64) * (D / 32) + (D / 64) * (D / 32) + (D / 64) * (DFF / 32) + (DFF / 64) * (D / 32), CONV_CHUNKS = LATE_ITEMS / 64;
static_assert(LATE_ITEMS % 64 == 0, "late conversion chunks");
__device__ __forceinline__ void convert_late_chunk(Frame& F, int l, int chunk) {
    LAS float* scr = (LAS float*)(F.lds + F.wave * 16384);
    constexpr int I_BR = (512 / 64) * (D / 32), I_OUT = (D / 64) * (D / 32), I_F1 = (D / 64) * (DFF / 32);
#pragma unroll 1
    for (int k = 0; k < 8; ++k) { int r = chunk * 64 + F.wave * 8 + k;
        if (r < I_BR) { transpose_item<0>(F.inp(I_WBM) + (size_t)l * 512 * D, 512, D, F.wsp<bf16_t>(WS_WBM), nullptr, scr, r, F.lane); continue; } r -= I_BR;
        if (r < I_BR) { transpose_item<0>(F.inp(I_WBA) + (size_t)l * 512 * D, 512, D, F.wsp<bf16_t>(WS_WBA), nullptr, scr, r, F.lane); continue; } r -= I_BR;
        if (r < I_BR) { transpose_item<0>(F.inp(I_WBD) + (size_t)l * 512 * D, 512, D, F.wsp<bf16_t>(WS_WBD), nullptr, scr, r, F.lane); continue; } r -= I_BR;
        if (r < I_OUT) { transpose_item<0>(F.inp(I_WOUT) + (size_t)l * D * D, D, D, F.wsp<bf16_t>(WS_WOUT), nullptr, scr, r, F.lane); continue; } r -= I_OUT;
        if (r < I_F1) { transpose_item<0>(F.inp(I_WFF1) + (size_t)l * D * DFF, D, DFF, F.wsp<bf16_t>(WS_W1), nullptr, scr, r, F.lane); continue; } r -= I_F1;
        transpose_item<0>(F.inp(I_WFF2) + (size_t)l * DFF * D, DFF, D, F.wsp<bf16_t>(WS_W2), nullptr, scr, r, F.lane); }
    __syncthreads();
}
__device__ __forceinline__ void phase_layer_prep(Frame& F, int l) {
    const int gw = F.bid * NWAVES + F.wave, NGW = F.G * NWAVES;
    const int gt = F.bid * NTHR + F.tid, NGT = F.G * NTHR;
    for (int i = gt; i < LB * PAST * KVR; i += NGT) { const int b = i / (PAST * KVR), r = i - b * PAST * KVR;
        F.wsp<bf16_t>(WS_CKVC)[i] = (bf16_t)f2bf(F.inp(I_CCKV)[((size_t)(b * DEPTH + l) * PAST) * KVR + r]); }
    for (int i = gt; i < LB * PAST * ROPA; i += NGT) { const int b = i / (PAST * ROPA), r = i - b * PAST * ROPA, t = r / ROPA, a = r % ROPA;
        F.wsp<bf16_t>(WS_KV)[(size_t)(NCTX + b * LT + t) * KVP + 1024 + 2 * (a & 15) + (a >> 4)] = (bf16_t)f2bf(F.inp(I_CKR)[((size_t)(b * DEPTH + l) * PAST + t) * ROPA + a]); }
    for (int i = gt; i < LB * PAST * 512; i += NGT) { const int b = i / (PAST * 512), r = i - b * PAST * 512, t = r >> 9, c = r & 511, j = c & 63;
        const size_t src = ((size_t)(b * DEPTH + l) * PAST + t) * 512 + c; const size_t kr_ = (size_t)(NCTX + b * LT + t) * 512;
        F.wsp<bf16_t>(WS_DK)[kr_ + (c & ~63) + 2 * (j & 31) + (j >> 5)] = (bf16_t)f2bf(F.inp(I_CDK)[src]);
        F.wsp<bf16_t>(WS_DV)[kr_ + c] = (bf16_t)f2bf(F.inp(I_CDV)[src]); }
    if (l == 0) { for (int row = gw; row < M; row += NGW * 2) rmsmod_rows<true, 2>(F, l, row, NGW, F.inp(I_N1G) + l * D, 1, 0); }
    else { for (int row = gw; row < M; row += NGW * 3) rmsmod_rows<false, 3>(F, l, row, NGW, F.inp(I_N1G) + l * D, 1, 0); }
}

__device__ __forceinline__ void phase_ckv_out(Frame& F, int l) {
    const int gt = F.bid * NTHR + F.tid, NGT = F.G * NTHR; const float* ss = (const float*)(F.ws + WS_CTL) + CW_SSKV + l * M;
    for (int i = gt; i < NCTX * KVR / 8; i += NGT) { const int row = i >> 5, c = (i & 31) * 8; const float r = rsqrtf(ss[row] * (1.f / KVR) + EPS);
        const u32x4 w = *(const u32x4*)(F.wsp<bf16_t>(WS_ACKV) + (size_t)row * KVR + c); const float* g = F.inp(I_KVNG) + l * KVR + c;
        float* o = F.out + O_CKV + ((size_t)((row >> 8) * DEPTH + l) * CS + (row & 255)) * KVR + c;
        *(f32x4*)o = (f32x4){lo_bf(w.x), hi_bf(w.x), lo_bf(w.y), hi_bf(w.y)} * r * *(const f32x4*)g;
        *(f32x4*)(o + 4) = (f32x4){lo_bf(w.z), hi_bf(w.z), lo_bf(w.w), hi_bf(w.w)} * r * *(const f32x4*)(g + 4); }
}

#define UNPACK8(dst, off, vv) do { dst[(off)] = lo_bf((vv)[0]); dst[(off) + 1] = hi_bf((vv)[0]); dst[(off) + 2] = lo_bf((vv)[1]); dst[(off) + 3] = hi_bf((vv)[1]); \
    dst[(off) + 4] = lo_bf((vv)[2]); dst[(off) + 5] = hi_bf((vv)[2]); dst[(off) + 6] = lo_bf((vv)[3]); dst[(off) + 7] = hi_bf((vv)[3]); } while (0)
__device__ __forceinline__ void mlstm_ref(Frame& F, int l) {
    LAS float* qs = (LAS float*)F.lds;
    LAS float* ks = qs + 64 * 65;
    LAS float* vs = ks + 64 * 65;
    LAS float* As = vs + 64 * 128;
    LAS float* Cs = As + 64 * 65;
    LAS float* ns = Cs + 64 * 128;
    LAS float* gs = ns + 64;
    LAS float* Ms = gs + 64;
    LAS float* bs = Ms + 64;
    LAS float* sc = bs + 64;
    const bf16_t* MQ = F.wsp<bf16_t>(WS_MQKVO); const float* MG = F.wsp<float>(WS_MG);
    const int tid = F.tid;
    for (int st = F.bid; st < (CB + LB) * 2 * HM; st += F.G) {
        const int head = st & 3, dir = (st >> 2) & 1, pb = st >> 3; const bool lat = pb >= CB;
        const int b = lat ? pb - CB : pb; const int N = lat ? LS : CS; const int row0 = lat ? NCTX + b * LS : b * CS; const int nc = N / 64;
        for (int i = tid; i < 64 * 128; i += NTHR) Cs[i] = lat ? F.inp(I_SC)[(((size_t)(b * DEPTH + l) * 2 + dir) * HM + head) * 64 * 128 + i] : 0.f;
        if (tid < 64) ns[tid] = lat ? F.inp(I_SN)[(((size_t)(b * DEPTH + l) * 2 + dir) * HM + head) * 64 + tid] : 0.f;
        if (tid == 0) sc[0] = lat ? F.inp(I_SM)[((size_t)(b * DEPTH + l) * 2 + dir) * HM + head] : 0.f;
        __syncthreads();
        for (int c = 0; c < nc; ++c) {
            for (int i = tid; i < 64 * 64; i += NTHR) { const int r = i >> 6, d = i & 63; const int tau = c * 64 + r, t = dir ? N - 1 - tau : tau; const size_t rb = (size_t)(row0 + t) * 1536;
                qs[r * 65 + d] = bf2f(MQ[rb + head * 64 + d]); ks[r * 65 + d] = bf2f(MQ[rb + 256 + head * 64 + d]); }
            for (int i = tid; i < 64 * 128; i += NTHR) { const int r = i >> 7, e = i & 127; const int tau = c * 64 + r, t = dir ? N - 1 - tau : tau;
                vs[r * 128 + e] = bf2f(MQ[(size_t)(row0 + t) * 1536 + 512 + head * 128 + e]); }
            if (tid < 64) { const int tau = c * 64 + tid, t = dir ? N - 1 - tau : tau; const float* g = MG + (size_t)(row0 + t) * 16;
                gs[tid] = g[dir * 4 + head]; bs[tid] = logsigmoidf_(g[8 + dir * 4 + head]); }
            __syncthreads();
            if (tid == 0) { float bb = 0.f, pm = -1e30f; const float m = sc[0];
                for (int i = 0; i < 64; ++i) { bb += bs[i]; bs[i] = bb; const float g = gs[i] - bb; gs[i] = g; pm = fmaxf(pm, g); Ms[i] = fmaxf(m, pm); } }
            __syncthreads();
            const float m = sc[0];
            for (int i = tid; i < 64 * 64; i += NTHR) { const int r = i >> 6, s = i & 63; float a = 0.f;
                if (s <= r) { float dt = 0.f;
#pragma unroll 8
                    for (int d = 0; d < 64; ++d) dt += qs[r * 65 + d] * ks[s * 65 + d];
                    a = expf(gs[s] - Ms[r]) * dt; }
                As[r * 65 + s] = a; }
            __syncthreads();
            if (tid < 64) { const int r = tid; float dn = 0.f, da = 0.f;
                for (int d = 0; d < 64; ++d) dn += qs[r * 65 + d] * ns[d];
                for (int s = 0; s < 64; ++s) da += As[r * 65 + s];
                const float den = expf(m - Ms[r]) * dn + da; const int tau = c * 64 + r, t = dir ? N - 1 - tau : tau;
                F.wsp<float>(WS_DEN)[(size_t)(row0 + t) * 8 + dir * 4 + head] = fmaxf(fabsf(den), expf(-(bs[r] + Ms[r]))); }
            for (int i = tid; i < 64 * 128; i += NTHR) { const int r = i >> 7, e = i & 127; float x = 0.f, y = 0.f;
#pragma unroll 8
                for (int d = 0; d < 64; ++d) x += qs[r * 65 + d] * Cs[d * 128 + e];
#pragma unroll 8
                for (int s = 0; s < 64; ++s) y += As[r * 65 + s] * vs[s * 128 + e];
                const int tau = c * 64 + r, t = dir ? N - 1 - tau : tau;
                F.wsp<bf16_t>(dir ? WS_HB : WS_HF)[(size_t)(row0 + t) * 512 + head * 128 + e] = (bf16_t)f2bf(expf(m - Ms[r]) * x + y); }
            __syncthreads();
            const float M63 = Ms[63], wold = expf(m - M63);
            for (int i = tid; i < 64 * 128; i += NTHR) { const int d = i >> 7, e = i & 127; float x = 0.f;
#pragma unroll 8
                for (int s = 0; s < 64; ++s) x += expf(gs[s] - M63) * ks[s * 65 + d] * vs[s * 128 + e];
                Cs[i] = wold * Cs[i] + x; }
            if (tid < 64) { float x = 0.f; for (int s = 0; s < 64; ++s) x += expf(gs[s] - M63) * ks[s * 65 + tid]; ns[tid] = wold * ns[tid] + x; }
            __syncthreads();
            if (tid == 0) sc[0] = bs[63] + M63;
            __syncthreads();
        }
        if (!lat) {
            const size_t sb = ((size_t)(b * DEPTH + l) * 2 + dir) * HM + head;
            for (int i = tid; i < 64 * 128; i += NTHR) F.out[O_C + sb * 64 * 128 + i] = Cs[i];
            if (tid < 64) F.out[O_N + sb * 64 + tid] = ns[tid];
            if (tid == 0) F.out[O_M + sb] = sc[0];
        }
        __syncthreads();
    }
}

namespace fa {
typedef float f32x16 __attribute__((ext_vector_type(16)));
typedef short s16x4 __attribute__((ext_vector_type(4)));
#define SBAR() __builtin_amdgcn_sched_barrier(0)
__device__ __forceinline__ int crow(int r, int hi) { return (r & 3) + 8 * (r >> 2) + 4 * hi; }
__device__ __forceinline__ unsigned cvtpk(float lo, float hi) { unsigned r; asm volatile("v_cvt_pk_bf16_f32 %0, %1, %2" : "=v"(r) : "v"(lo), "v"(hi)); return r; }
constexpr float THR = 8.f;
template <int NCB> __device__ __forceinline__ int v_st(int k, int c) { const int kk = (k & ~0xC) | ((k & 4) << 1) | ((k & 8) >> 1); return ((kk >> 3) * NCB + (c >> 5)) * 512 + ((kk & 7) * 32 + (c & 31)) * 2; }
__device__ __forceinline__ int v_rd_base(int lane) { return ((lane & 3) << 3) | (((lane >> 2) & 3) << 6) | (((lane >> 4) & 1) << 5) | (((lane >> 5) & 1) << 8); }
template <int NCB> constexpr int v_rd_off(int d0, int ks, int half) { return d0 * 512 + ks * NCB * 1024 + half * NCB * 512; }
template <int OFF> __device__ __forceinline__ s16x4 tr_read(int vb) { s16x4 r; asm volatile("ds_read_b64_tr_b16 %0, %1 offset:%2" : "=&v"(r) : "v"(vb), "i"(OFF) : "memory"); return r; }
template <int NCB, int D0, int BO> __device__ __forceinline__ void pv_one(f32x16& od, int vb, bf16x8 pa0, bf16x8 pa1, bf16x8 pa2, bf16x8 pa3) {
    const s16x4 l0 = tr_read<BO + v_rd_off<NCB>(D0, 0, 0)>(vb), h0 = tr_read<BO + v_rd_off<NCB>(D0, 0, 1)>(vb), l1 = tr_read<BO + v_rd_off<NCB>(D0, 1, 0)>(vb), h1 = tr_read<BO + v_rd_off<NCB>(D0, 1, 1)>(vb);
    const s16x4 l2 = tr_read<BO + v_rd_off<NCB>(D0, 2, 0)>(vb), h2 = tr_read<BO + v_rd_off<NCB>(D0, 2, 1)>(vb), l3 = tr_read<BO + v_rd_off<NCB>(D0, 3, 0)>(vb), h3 = tr_read<BO + v_rd_off<NCB>(D0, 3, 1)>(vb);
    asm volatile("s_waitcnt lgkmcnt(0)" ::: "memory"); SBAR();
#define PK(L, H) (bf16x8){L[0], L[1], L[2], L[3], H[0], H[1], H[2], H[3]}
    od = __builtin_amdgcn_mfma_f32_32x32x16_bf16(pa0, PK(l0, h0), od, 0, 0, 0);
    od = __builtin_amdgcn_mfma_f32_32x32x16_bf16(pa1, PK(l1, h1), od, 0, 0, 0);
    od = __builtin_amdgcn_mfma_f32_32x32x16_bf16(pa2, PK(l2, h2), od, 0, 0, 0);
    od = __builtin_amdgcn_mfma_f32_32x32x16_bf16(pa3, PK(l3, h3), od, 0, 0, 0);
#undef PK
}
template <int NCB, int D0, int BO> __device__ __forceinline__ void pv_two(f32x16& oa, f32x16& ob, int vb, bf16x8 pa0, bf16x8 pa1, bf16x8 pa2, bf16x8 pa3) {
    const s16x4 l0 = tr_read<BO + v_rd_off<NCB>(D0, 0, 0)>(vb), h0 = tr_read<BO + v_rd_off<NCB>(D0, 0, 1)>(vb), m0 = tr_read<BO + v_rd_off<NCB>(D0 + 1, 0, 0)>(vb), n0 = tr_read<BO + v_rd_off<NCB>(D0 + 1, 0, 1)>(vb);
    const s16x4 l1 = tr_read<BO + v_rd_off<NCB>(D0, 1, 0)>(vb), h1 = tr_read<BO + v_rd_off<NCB>(D0, 1, 1)>(vb), m1 = tr_read<BO + v_rd_off<NCB>(D0 + 1, 1, 0)>(vb), n1 = tr_read<BO + v_rd_off<NCB>(D0 + 1, 1, 1)>(vb);
    const s16x4 l2 = tr_read<BO + v_rd_off<NCB>(D0, 2, 0)>(vb), h2 = tr_read<BO + v_rd_off<NCB>(D0, 2, 1)>(vb), m2 = tr_read<BO + v_rd_off<NCB>(D0 + 1, 2, 0)>(vb), n2 = tr_read<BO + v_rd_off<NCB>(D0 + 1, 2, 1)>(vb);
    const s16x4 l3 = tr_read<BO + v_rd_off<NCB>(D0, 3, 0)>(vb), h3 = tr_read<BO + v_rd_off<NCB>(D0, 3, 1)>(vb), m3 = tr_read<BO + v_rd_off<NCB>(D0 + 1, 3, 0)>(vb), n3 = tr_read<BO + v_rd_off<NCB>(D0 + 1, 3, 1)>(vb);
    asm volatile("s_waitcnt lgkmcnt(0)" ::: "memory"); SBAR();
#define PK(L, H) (bf16x8){L[0], L[1], L[2], L[3], H[0], H[1], H[2], H[3]}
    oa = __builtin_amdgcn_mfma_f32_32x32x16_bf16(pa0, PK(l0, h0), oa, 0, 0, 0); ob = __builtin_amdgcn_mfma_f32_32x32x16_bf16(pa0, PK(m0, n0), ob, 0, 0, 0);
    oa = __builtin_amdgcn_mfma_f32_32x32x16_bf16(pa1, PK(l1, h1), oa, 0, 0, 0); ob = __builtin_amdgcn_mfma_f32_32x32x16_bf16(pa1, PK(m1, n1), ob, 0, 0, 0);
    oa = __builtin_amdgcn_mfma_f32_32x32x16_bf16(pa2, PK(l2, h2), oa, 0, 0, 0); ob = __builtin_amdgcn_mfma_f32_32x32x16_bf16(pa2, PK(m2, n2), ob, 0, 0, 0);
    oa = __builtin_amdgcn_mfma_f32_32x32x16_bf16(pa3, PK(l3, h3), oa, 0, 0, 0); ob = __builtin_amdgcn_mfma_f32_32x32x16_bf16(pa3, PK(m3, n3), ob, 0, 0, 0);
#undef PK
}
struct VFrag { s16x4 l0, h0, l1, h1, l2, h2, l3, h3; };
template <int NCB, int D0> __device__ __forceinline__ void pv_reads(VFrag& f, int vb) {
    f.l0 = tr_read<v_rd_off<NCB>(D0, 0, 0)>(vb); f.h0 = tr_read<v_rd_off<NCB>(D0, 0, 1)>(vb); f.l1 = tr_read<v_rd_off<NCB>(D0, 1, 0)>(vb); f.h1 = tr_read<v_rd_off<NCB>(D0, 1, 1)>(vb);
    f.l2 = tr_read<v_rd_off<NCB>(D0, 2, 0)>(vb); f.h2 = tr_read<v_rd_off<NCB>(D0, 2, 1)>(vb); f.l3 = tr_read<v_rd_off<NCB>(D0, 3, 0)>(vb); f.h3 = tr_read<v_rd_off<NCB>(D0, 3, 1)>(vb);
}
__device__ __forceinline__ void pv_mfmas(f32x16& od, const VFrag& f, bf16x8 pa0, bf16x8 pa1, bf16x8 pa2, bf16x8 pa3) {
#define PK(L, H) (bf16x8){L[0], L[1], L[2], L[3], H[0], H[1], H[2], H[3]}
    od = __builtin_amdgcn_mfma_f32_32x32x16_bf16(pa0, PK(f.l0, f.h0), od, 0, 0, 0);
    od = __builtin_amdgcn_mfma_f32_32x32x16_bf16(pa1, PK(f.l1, f.h1), od, 0, 0, 0);
    od = __builtin_amdgcn_mfma_f32_32x32x16_bf16(pa2, PK(f.l2, f.h2), od, 0, 0, 0);
    od = __builtin_amdgcn_mfma_f32_32x32x16_bf16(pa3, PK(f.l3, f.h3), od, 0, 0, 0);
#undef PK
}
__device__ __forceinline__ void pack_p(const f32x16& p0, const f32x16& p1, bf16x8& pa0, bf16x8& pa1, bf16x8& pa2, bf16x8& pa3) {
#define PK4(P, BASE, OUT) do { unsigned a0 = cvtpk(P[BASE + 0], P[BASE + 1]), a1 = cvtpk(P[BASE + 2], P[BASE + 3]);   \
    unsigned b0 = cvtpk(P[BASE + 4], P[BASE + 5]), b1 = cvtpk(P[BASE + 6], P[BASE + 7]);                              \
    auto r0 = __builtin_amdgcn_permlane32_swap(a0, b0, false, false); auto r1 = __builtin_amdgcn_permlane32_swap(a1, b1, false, false); \
    u32x4 w = {r0[0], r1[0], r0[1], r1[1]}; OUT = *reinterpret_cast<bf16x8*>(&w); } while (0)
    PK4(p0, 0, pa0); PK4(p0, 8, pa1); PK4(p1, 0, pa2); PK4(p1, 8, pa3);
#undef PK4
}
struct Src {
    const bf16_t* q; int qpitch;
    const unsigned char* base;
    unsigned kA, kB, v; int nchA;
    int pitch; int T;
};
template <int DQK, int DV> struct Geo {
    static constexpr int NCHK = DQK / 8, NCHV = DV / 8, NCB = DV / 32, KSTR = DQK * 2 + 16, KBYTES = 64 * KSTR, VBYTES = 64 * DV * 2;
    static constexpr int BUFB = KBYTES + VBYTES, OFF_WS = 3 * BUFB;
    static constexpr int OFF_RED = OFF_WS + NWAVES * 64 * 4, BYTES = OFF_RED + NWAVES * 32 * 33 * 4;
    static constexpr int NK = 64 * NCHK, NV = 64 * NCHV, TOT = NK + NV, NPT = (TOT + NTHR - 1) / NTHR;
};
template <int DQK, int DV>
__device__ __forceinline__ void attn_pass(const Src& S, LAS unsigned char* lds, int tid, float C, f32x16 (&o)[DV / 32], float& l_out) {
    typedef Geo<DQK, DV> G;
    const int wid = __builtin_amdgcn_readfirstlane(tid >> 6), lane = tid & 63, r32 = lane & 31, hi = lane >> 5;
    const bool late = wid >= 4;
    LAS float* al_l = (LAS float*)(lds + G::OFF_WS) + wid * 64;
    bf16x8 qr[DQK / 16];
    { const bf16_t* Qw = S.q + (size_t)(wid * 32 + r32) * S.qpitch + hi * 8;
#pragma unroll
      for (int d0 = 0; d0 < DQK / 16; ++d0) qr[d0] = *(const bf16x8*)(Qw + d0 * 16); }
    const unsigned pitchB = (unsigned)S.pitch * 2u, stepB = pitchB * 64u;
    unsigned soff[G::NPT]; int sdst[G::NPT];
#pragma unroll
    for (int i = 0; i < G::NPT; ++i) { int idx = tid + NTHR * i; if (idx >= G::TOT) idx -= NTHR;
        if (idx < G::NK) { const int key = idx / G::NCHK, ch = idx - key * G::NCHK;
            soff[i] = S.kA + (unsigned)key * pitchB + ch * 16;
            if constexpr (DQK == QKA) { if (ch >= S.nchA) soff[i] = S.kB + (unsigned)key * pitchB + (ch - S.nchA) * 16; }
            sdst[i] = key * G::KSTR + ch * 16; }
        else { const int j = idx - G::NK, key = j / G::NCHV, ch = j - key * G::NCHV;
            soff[i] = S.v + (unsigned)key * pitchB + ch * 16; sdst[i] = G::KBYTES + v_st<G::NCB>(key, ch * 8); } }
    bf16x8 st[G::NPT];
#define FA_SLOAD(t) do { const unsigned char* bt_ = S.base + (size_t)(t) * stepB; _Pragma("unroll") for (int i = 0; i < G::NPT; ++i) st[i] = *(const bf16x8*)(bt_ + soff[i]); } while (0)
#define FA_SWRITE(bo_) do { _Pragma("unroll") for (int i = 0; i < G::NPT; ++i) *(LAS bf16x8*)(lds + sdst[i] + (bo_)) = st[i]; } while (0)
#define FA_QKT(bo_) do { p0 = f32x16{}; p1 = f32x16{}; LAS unsigned char* Ks_ = lds + (bo_); \
        _Pragma("unroll") for (int d0 = 0; d0 < DQK / 16; ++d0) { const int cb = (d0 * 16 + hi * 8) * 2; \
            const bf16x8 b0 = *(const LAS bf16x8*)(Ks_ + r32 * G::KSTR + cb), b1 = *(const LAS bf16x8*)(Ks_ + (32 + r32) * G::KSTR + cb); \
            p0 = __builtin_amdgcn_mfma_f32_32x32x16_bf16(b0, qr[d0], p0, 0, 0, 0); p1 = __builtin_amdgcn_mfma_f32_32x32x16_bf16(b1, qr[d0], p1, 0, 0, 0); } } while (0)
#define FA_LGKM(n) do { asm volatile("s_waitcnt lgkmcnt(" #n ")" ::: "memory"); SBAR(); } while (0)
#define FA_PV(bo_) do { const int vb_ = vb0 + (bo_); \
        if constexpr (DV == 128) { pv_two<G::NCB, 0, 0>(o[0], o[1], vb_, pa0, pa1, pa2, pa3); pv_two<G::NCB, 2, 0>(o[2], o[3], vb_, pa0, pa1, pa2, pa3); } \
        else { VFrag fa_, fb_; pv_reads<G::NCB, 0>(fa_, vb_); pv_reads<G::NCB, 1>(fb_, vb_); \
            FA_LGKM(8); pv_mfmas(o[0], fa_, pa0, pa1, pa2, pa3); SBAR(); FA_LGKM(0); pv_mfmas(o[1], fb_, pa0, pa1, pa2, pa3); } } while (0)
#define FA_SOFTMAX() do { float pmax = p0[0]; \
        _Pragma("unroll") for (int r = 1; r < 16; ++r) pmax = fmaxf(pmax, p0[r]); _Pragma("unroll") for (int r = 0; r < 16; ++r) pmax = fmaxf(pmax, p1[r]); \
        { auto rr = __builtin_amdgcn_permlane32_swap(__float_as_uint(pmax), __float_as_uint(pmax), false, false); pmax = fmaxf(__uint_as_float(rr[0]), __uint_as_float(rr[1])); } \
        float al_ = 1.f; \
        if (!__builtin_expect(__all(pmax - m_reg <= invC_thr), 1)) { const float mn = fmaxf(m_reg, pmax); al_ = __builtin_amdgcn_exp2f((m_reg - mn) * C); m_reg = mn; \
            if (hi == 0) al_l[r32] = al_; asm volatile("s_waitcnt lgkmcnt(0)" ::: "memory"); \
            _Pragma("unroll") for (int d = 0; d < DV / 32; ++d) _Pragma("unroll") for (int r = 0; r < 16; ++r) o[d][r] *= al_l[crow(r, hi)]; } \
        const float mnC = -m_reg * C; \
        _Pragma("unroll") for (int r = 0; r < 16; ++r) p0[r] = __builtin_amdgcn_exp2f(fmaf(p0[r], C, mnC)); _Pragma("unroll") for (int r = 0; r < 16; ++r) p1[r] = __builtin_amdgcn_exp2f(fmaf(p1[r], C, mnC)); \
        float ps = 0.f; _Pragma("unroll") for (int r = 0; r < 16; ++r) ps += p0[r]; _Pragma("unroll") for (int r = 0; r < 16; ++r) ps += p1[r]; \
        { auto rr = __builtin_amdgcn_permlane32_swap(__float_as_uint(ps), __float_as_uint(ps), false, false); ps = __uint_as_float(rr[0]) + __uint_as_float(rr[1]); } \
        l_reg = l_reg * al_ + ps; pack_p(p0, p1, pa0, pa1, pa2, pa3); } while (0)
#define FA_BAR() do { asm volatile("s_waitcnt lgkmcnt(0)" ::: "memory"); __builtin_amdgcn_s_barrier(); asm volatile("" ::: "memory"); } while (0)
    const int NT = S.T / 64;
    float m_reg = -1e30f, l_reg = 0.f;
#pragma unroll
    for (int d = 0; d < DV / 32; ++d) o[d] = f32x16{};
    const int vb0 = (int)(uintptr_t)(lds + G::KBYTES) + v_rd_base(lane);
    const float invC_thr = THR * 1.4426950408889634f / C;
    f32x16 p0, p1; bf16x8 pa0, pa1, pa2, pa3;
    FA_SLOAD(0); FA_SWRITE(0); FA_SLOAD(1); FA_BAR();
    if (late) __builtin_amdgcn_s_barrier();
    FA_SWRITE(G::BUFB); FA_SLOAD(2); SBAR(); FA_QKT(0); FA_BAR();
    FA_SOFTMAX(); FA_BAR();
    int bo_prev = 0, bo = G::BUFB, bo_next = 2 * G::BUFB;
#pragma unroll 1
    for (int t = 1; t < NT; ++t) {
        FA_SWRITE(bo_next); { const int tn = t + 2 < NT ? t + 2 : NT - 1; FA_SLOAD(tn); } SBAR();
        FA_QKT(bo); SBAR(); FA_PV(bo_prev);
        FA_BAR();
        FA_SOFTMAX();
        FA_BAR();
        bo_prev = bo; bo = bo_next; bo_next = bo_next == 2 * G::BUFB ? 0 : bo_next + G::BUFB;
    }
    FA_PV(bo_prev);
    if (!late) __builtin_amdgcn_s_barrier();
    FA_BAR();
    l_out = l_reg;
#undef FA_SLOAD
#undef FA_SWRITE
#undef FA_QKT
#undef FA_PV
#undef FA_LGKM
#undef FA_SOFTMAX
#undef FA_BAR
}
template <int NB> __device__ __forceinline__ void normalize(f32x16 (&o)[NB], float l_reg, LAS float* wsf, int r32, int hi, float mul) {
    if (hi == 0) wsf[32 + r32] = l_reg; asm volatile("s_waitcnt lgkmcnt(0)" ::: "memory");
#pragma unroll
    for (int r = 0; r < 16; ++r) { const float rl = mul * __builtin_amdgcn_rcpf(wsf[32 + crow(r, hi)]);
#pragma unroll
        for (int d = 0; d < NB; ++d) o[d][r] *= rl; }
    asm volatile("s_waitcnt lgkmcnt(0)" ::: "memory");
}
}

namespace ml {
using fa::f32x16; using fa::s16x4; using fa::crow; using fa::cvtpk; using fa::v_st; using fa::v_rd_base; using fa::v_rd_off; using fa::tr_read;
constexpr int WAVE_LDS = 16384;
constexpr int ARR_OFF = LDSCTL_OFF + 1024, ARR_WAVE = 1280;
static_assert(ARR_OFF + NWAVES * ARR_WAVE <= LDS_BYTES, "mlstm lds");
__device__ __forceinline__ bf16x8 pk4(const f32x16& P, int base_is_8) {
    unsigned a0, a1, b0, b1;
    if (base_is_8) { a0 = cvtpk(P[8], P[9]); a1 = cvtpk(P[10], P[11]); b0 = cvtpk(P[12], P[13]); b1 = cvtpk(P[14], P[15]); }
    else { a0 = cvtpk(P[0], P[1]); a1 = cvtpk(P[2], P[3]); b0 = cvtpk(P[4], P[5]); b1 = cvtpk(P[6], P[7]); }
    auto r0 = __builtin_amdgcn_permlane32_swap(a0, b0, false, false); auto r1 = __builtin_amdgcn_permlane32_swap(a1, b1, false, false);
    u32x4 w = {r0[0], r1[0], r0[1], r1[1]}; return *reinterpret_cast<bf16x8*>(&w);
}
template <int NCB, int D0, int KS> __device__ __forceinline__ bf16x8 tr_frag(int vb) {
    const s16x4 lo = tr_read<v_rd_off<NCB>(D0, KS, 0)>(vb), hi = tr_read<v_rd_off<NCB>(D0, KS, 1)>(vb);
    asm volatile("s_waitcnt lgkmcnt(0)" ::: "memory"); __builtin_amdgcn_sched_barrier(0);
    return (bf16x8){lo[0], lo[1], lo[2], lo[3], hi[0], hi[1], hi[2], hi[3]};
}
template <int NCB, int D0> __device__ __forceinline__ void tr_frag4(int vb, bf16x8& f0, bf16x8& f1, bf16x8& f2, bf16x8& f3) {
    const s16x4 l0 = tr_read<v_rd_off<NCB>(D0, 0, 0)>(vb), h0 = tr_read<v_rd_off<NCB>(D0, 0, 1)>(vb), l1 = tr_read<v_rd_off<NCB>(D0, 1, 0)>(vb), h1 = tr_read<v_rd_off<NCB>(D0, 1, 1)>(vb);
    const s16x4 l2 = tr_read<v_rd_off<NCB>(D0, 2, 0)>(vb), h2 = tr_read<v_rd_off<NCB>(D0, 2, 1)>(vb), l3 = tr_read<v_rd_off<NCB>(D0, 3, 0)>(vb), h3 = tr_read<v_rd_off<NCB>(D0, 3, 1)>(vb);
    asm volatile("s_waitcnt lgkmcnt(0)" ::: "memory"); __builtin_amdgcn_sched_barrier(0);
    f0 = (bf16x8){l0[0], l0[1], l0[2], l0[3], h0[0], h0[1], h0[2], h0[3]}; f1 = (bf16x8){l1[0], l1[1], l1[2], l1[3], h1[0], h1[1], h1[2], h1[3]};
    f2 = (bf16x8){l2[0], l2[1], l2[2], l2[3], h2[0], h2[1], h2[2], h2[3]}; f3 = (bf16x8){l3[0], l3[1], l3[2], l3[3], h3[0], h3[1], h3[2], h3[3]};
}
#define ML_DPP(ident, v, ctrl, rmask) __int_as_float(__builtin_amdgcn_update_dpp(__float_as_int(ident), __float_as_int(v), ctrl, rmask, 0xf, false))
__device__ __forceinline__ float scan_add(float x, int lane) {
    x += ML_DPP(0.f, x, 0x111, 0xf); x += ML_DPP(0.f, x, 0x112, 0xf); x += ML_DPP(0.f, x, 0x114, 0xf); x += ML_DPP(0.f, x, 0x118, 0xf);
    x += ML_DPP(0.f, x, 0x142, 0xa); x += ML_DPP(0.f, x, 0x143, 0xc);
    return x;
}
__device__ __forceinline__ float scan_max(float x, int lane) {
    const float ni = -3.0e38f;
    x = fmaxf(x, ML_DPP(ni, x, 0x111, 0xf)); x = fmaxf(x, ML_DPP(ni, x, 0x112, 0xf)); x = fmaxf(x, ML_DPP(ni, x, 0x114, 0xf)); x = fmaxf(x, ML_DPP(ni, x, 0x118, 0xf));
    x = fmaxf(x, ML_DPP(ni, x, 0x142, 0xa)); x = fmaxf(x, ML_DPP(ni, x, 0x143, 0xc));
    return x;
}
template <bool STATE_ONLY>
__device__ __forceinline__ void wave_task(Frame& F, int l, int pb, int dir, int head, int sl, int seg) {
    const int lane = F.lane, r32 = lane & 31, hi = lane >> 5, wave = F.wave;
    const bool lat = pb >= CB; const int b = lat ? pb - CB : pb; const int N = lat ? LS : CS; const int row0 = lat ? NCTX + b * LS : b * CS;
    const int c0 = lat ? seg * ML_SEGCH : 0, c1 = lat ? c0 + ML_SEGCH : CS / 64;
    LAS unsigned char* wl = F.lds + wave * WAVE_LDS;
    LAS unsigned char* KT = wl; LAS unsigned char* VT = wl + 8192; LAS unsigned char* VW = wl + 12288;
    LAS float* gL = (LAS float*)(F.lds + ARR_OFF + wave * ARR_WAVE); LAS float* ML = gL + 64; LAS float* wiL = gL + 128; LAS float* bL = gL + 192;
    const int kt_rd = (int)(uintptr_t)KT + v_rd_base(lane), vt_rd = (int)(uintptr_t)VT + v_rd_base(lane), vw_rd = (int)(uintptr_t)VW + v_rd_base(lane);
    const bf16_t* MQ = F.wsp<bf16_t>(WS_MQKVO); const float* MG = F.wsp<float>(WS_MG);
    const size_t sbase = ((size_t)(b * DEPTH + l) * 2 + dir) * HM + head;
    float* slab0 = F.wsp<float>(WS_SLAB) + ((size_t)(((b * 2 + dir) * HM + head) * 5 + sl) * ML_NSEG) * SLAB_F;
    f32x16 Cacc[2]; float m; float bsum = 0.f;
    if (STATE_ONLY) { m = -1e30f; Cacc[0] = f32x16{}; Cacc[1] = f32x16{}; }
    else if (lat) {
        m = F.inp(I_SM)[sbase];
#pragma unroll
        for (int db = 0; db < 2; ++db)
#pragma unroll
            for (int r = 0; r < 16; ++r) { const int d = 32 * db + crow(r, hi);
                Cacc[db][r] = sl < 4 ? F.inp(I_SC)[(sbase * 64 + d) * 128 + sl * 32 + r32] : F.inp(I_SN)[sbase * 64 + d]; }
#pragma unroll 1
        for (int sp0 = 0; sp0 < seg; sp0 += 4) {
            float sv[4][32], sm_[4], sbs_[4];
#pragma unroll
            for (int k = 0; k < 4; ++k) { const int sp = sp0 + k < seg ? sp0 + k : seg - 1; const float* sb_ = slab0 + (size_t)sp * SLAB_F; sm_[k] = sb_[2048]; sbs_[k] = sb_[2049];
#pragma unroll
                for (int q = 0; q < 32; ++q) sv[k][q] = sb_[q * 64 + lane]; }
#pragma unroll
            for (int k = 0; k < 4; ++k) if (sp0 + k < seg) {
                const float mn = fmaxf(m + sbs_[k], sm_[k]), w0 = __expf(m + sbs_[k] - mn), w1 = __expf(sm_[k] - mn);
#pragma unroll
                for (int db = 0; db < 2; ++db)
#pragma unroll
                    for (int r = 0; r < 16; ++r) Cacc[db][r] = w0 * Cacc[db][r] + w1 * sv[k][db * 16 + r];
                m = mn; } }
    } else { m = 0.f; Cacc[0] = f32x16{}; Cacc[1] = f32x16{}; }
#pragma unroll 1
    for (int c = c0; c < c1; ++c) {
        const int tau = c * 64 + lane, t = dir ? N - 1 - tau : tau; const size_t row = (size_t)(row0 + t);
        const float li = MG[row * 16 + dir * 4 + head], gf_ = MG[row * 16 + 8 + dir * 4 + head];
        const float lf = fminf(gf_, 0.f) - 0.6931471805599453f * __builtin_amdgcn_logf(1.f + __builtin_amdgcn_exp2f(-1.4426950408889634f * fabsf(gf_)));
#pragma unroll
        for (int ch = 0; ch < 8; ++ch) *(LAS u32x4*)(KT + v_st<2>(lane, ch * 8)) = *(const u32x4*)(MQ + row * 1536 + 256 + head * 64 + ch * 8);
        u32x4 vraw[4];
        if (sl < 4) {
#pragma unroll
            for (int ch = 0; ch < 4; ++ch) vraw[ch] = *(const u32x4*)(MQ + row * 1536 + 512 + head * 128 + sl * 32 + ch * 8);
        } else {
#pragma unroll
            for (int ch = 0; ch < 4; ++ch) vraw[ch] = (u32x4){0x3f803f80u, 0x3f803f80u, 0x3f803f80u, 0x3f803f80u};
        }
        bf16x8 qf[2][4];
        if (!STATE_ONLY)
#pragma unroll
        for (int ib = 0; ib < 2; ++ib) { const int tq = c * 64 + 32 * ib + r32, tt = dir ? N - 1 - tq : tq; const bf16_t* qp = MQ + (size_t)(row0 + tt) * 1536 + head * 64 + hi * 8;
#pragma unroll
            for (int ks = 0; ks < 4; ++ks) qf[ib][ks] = *(const bf16x8*)(qp + ks * 16); }
        const float bcum = scan_add(lf, lane), g = li - bcum, pm = scan_max(g, lane), Mi = fmaxf(m, pm);
        const float M63 = __int_as_float(__builtin_amdgcn_readlane(__float_as_int(Mi), 63)), b63 = __int_as_float(__builtin_amdgcn_readlane(__float_as_int(bcum), 63));
        const float wi = __expf(m - Mi), wsl = __expf(g - M63), wold = __expf(m - M63);
        gL[lane] = g; ML[lane] = Mi; wiL[lane] = wi; bL[lane] = bcum;
#pragma unroll
        for (int ch = 0; ch < 4; ++ch) { if (!STATE_ONLY) *(LAS u32x4*)(VT + v_st<1>(lane, ch * 8)) = vraw[ch];
            u32x4 w;
#pragma unroll
            for (int e = 0; e < 4; ++e) w[e] = pk2(lo_bf(vraw[ch][e]) * wsl, hi_bf(vraw[ch][e]) * wsl);
            *(LAS u32x4*)(VW + v_st<1>(lane, ch * 8)) = w; }
        asm volatile("s_waitcnt lgkmcnt(0)" ::: "memory");
        if (!STATE_ONLY) {
        bf16x8 a00[2], a01[2], a11[2];
        { f32x16 P00 = f32x16{}, P01 = f32x16{}, P11 = f32x16{};
#pragma unroll
          for (int ks = 0; ks < 4; ++ks) {
              const bf16x8 k0 = *(const LAS bf16x8*)(KT + v_st<2>(r32, ks * 16 + hi * 8)), k1 = *(const LAS bf16x8*)(KT + v_st<2>(32 + r32, ks * 16 + hi * 8));
              P00 = __builtin_amdgcn_mfma_f32_32x32x16_bf16(k0, qf[0][ks], P00, 0, 0, 0);
              P01 = __builtin_amdgcn_mfma_f32_32x32x16_bf16(k0, qf[1][ks], P01, 0, 0, 0);
              P11 = __builtin_amdgcn_mfma_f32_32x32x16_bf16(k1, qf[1][ks], P11, 0, 0, 0);
          }
          const float M0 = ML[r32], M1 = ML[32 + r32];
#pragma unroll
          for (int q = 0; q < 4; ++q) { const f32x4 g0 = *(const LAS f32x4*)(gL + 8 * q + 4 * hi), g1 = *(const LAS f32x4*)(gL + 32 + 8 * q + 4 * hi);
#pragma unroll
              for (int j = 0; j < 4; ++j) { const int r = 4 * q + j; const int sl_ = j + 8 * q + 4 * hi;
                  P00[r] = (sl_ <= r32) ? P00[r] * __expf(g0[j] - M0) : 0.f;
                  P01[r] = P01[r] * __expf(g0[j] - M1);
                  P11[r] = (sl_ <= r32) ? P11[r] * __expf(g1[j] - M1) : 0.f; } }
          a00[0] = pk4(P00, 0); a00[1] = pk4(P00, 1); a01[0] = pk4(P01, 0); a01[1] = pk4(P01, 1); a11[0] = pk4(P11, 0); a11[1] = pk4(P11, 1); }
        f32x16 Y0 = f32x16{}, Y1 = f32x16{};
#pragma unroll
        for (int db = 0; db < 2; ++db)
#pragma unroll
            for (int kk = 0; kk < 2; ++kk) { const bf16x8 cf = pk4(Cacc[db], kk);
                Y0 = __builtin_amdgcn_mfma_f32_32x32x16_bf16(qf[0][2 * db + kk], cf, Y0, 0, 0, 0);
                Y1 = __builtin_amdgcn_mfma_f32_32x32x16_bf16(qf[1][2 * db + kk], cf, Y1, 0, 0, 0); }
#pragma unroll
        for (int q = 0; q < 4; ++q) { const f32x4 w0 = *(const LAS f32x4*)(wiL + 8 * q + 4 * hi), w1 = *(const LAS f32x4*)(wiL + 32 + 8 * q + 4 * hi);
#pragma unroll
            for (int j = 0; j < 4; ++j) { Y0[4 * q + j] *= w0[j]; Y1[4 * q + j] *= w1[j]; } }
        { bf16x8 v0, v1, v2, v3; tr_frag4<1, 0>(vt_rd, v0, v1, v2, v3);
          Y0 = __builtin_amdgcn_mfma_f32_32x32x16_bf16(a00[0], v0, Y0, 0, 0, 0); Y0 = __builtin_amdgcn_mfma_f32_32x32x16_bf16(a00[1], v1, Y0, 0, 0, 0);
          Y1 = __builtin_amdgcn_mfma_f32_32x32x16_bf16(a01[0], v0, Y1, 0, 0, 0); Y1 = __builtin_amdgcn_mfma_f32_32x32x16_bf16(a01[1], v1, Y1, 0, 0, 0);
          Y1 = __builtin_amdgcn_mfma_f32_32x32x16_bf16(a11[0], v2, Y1, 0, 0, 0); Y1 = __builtin_amdgcn_mfma_f32_32x32x16_bf16(a11[1], v3, Y1, 0, 0, 0); }
        { const int rstep = dir ? -512 : 512; const int tb = dir ? N - 1 - c * 64 : c * 64;
          if (sl < 4) {
            bf16_t* H = F.wsp<bf16_t>(dir ? WS_HB : WS_HF) + (size_t)row0 * 512 + head * 128 + sl * 32;
            int off = tb * 512 + r32 + rstep * (4 * hi);
#pragma unroll
            for (int r = 0; r < 16; ++r) { const int o0 = off + rstep * ((r & 3) + 8 * (r >> 2));
                H[o0] = (bf16_t)f2bf(Y0[r]); H[o0 + rstep * 32] = (bf16_t)f2bf(Y1[r]); }
          } else if (r32 == 0) {
            float* DN = F.wsp<float>(WS_DEN) + (size_t)row0 * 8 + dir * 4 + head; const int rs8 = dir ? -8 : 8;
#pragma unroll
            for (int r = 0; r < 16; ++r) { const int il = crow(r, hi); const int o0 = tb * 8 + rs8 * il;
                DN[o0] = fmaxf(fabsf(Y0[r]), __expf(-(bL[il] + ML[il]))); DN[o0 + rs8 * 32] = fmaxf(fabsf(Y1[r]), __expf(-(bL[32 + il] + ML[32 + il]))); }
          } }
        }
#pragma unroll
        for (int r = 0; r < 16; ++r) { Cacc[0][r] *= wold; Cacc[1][r] *= wold; }
        { bf16x8 w0, w1, w2, w3, k0, k1, k2, k3; tr_frag4<1, 0>(vw_rd, w0, w1, w2, w3); tr_frag4<2, 0>(kt_rd, k0, k1, k2, k3);
          Cacc[0] = __builtin_amdgcn_mfma_f32_32x32x16_bf16(k0, w0, Cacc[0], 0, 0, 0); Cacc[0] = __builtin_amdgcn_mfma_f32_32x32x16_bf16(k1, w1, Cacc[0], 0, 0, 0);
          Cacc[0] = __builtin_amdgcn_mfma_f32_32x32x16_bf16(k2, w2, Cacc[0], 0, 0, 0); Cacc[0] = __builtin_amdgcn_mfma_f32_32x32x16_bf16(k3, w3, Cacc[0], 0, 0, 0);
          tr_frag4<2, 1>(kt_rd, k0, k1, k2, k3);
          Cacc[1] = __builtin_amdgcn_mfma_f32_32x32x16_bf16(k0, w0, Cacc[1], 0, 0, 0); Cacc[1] = __builtin_amdgcn_mfma_f32_32x32x16_bf16(k1, w1, Cacc[1], 0, 0, 0);
          Cacc[1] = __builtin_amdgcn_mfma_f32_32x32x16_bf16(k2, w2, Cacc[1], 0, 0, 0); Cacc[1] = __builtin_amdgcn_mfma_f32_32x32x16_bf16(k3, w3, Cacc[1], 0, 0, 0); }
        m = b63 + M63; bsum += b63;
        asm volatile("s_waitcnt lgkmcnt(0)" ::: "memory");
    }
    if (STATE_ONLY) {
        float* sb_ = slab0 + (size_t)seg * SLAB_F;
#pragma unroll
        for (int db = 0; db < 2; ++db)
#pragma unroll
            for (int r = 0; r < 16; ++r) sb_[(db * 16 + r) * 64 + lane] = Cacc[db][r];
        if (lane == 0) { sb_[2048] = m; sb_[2049] = bsum; }
    } else if (!lat) {
        if (sl < 4) {
#pragma unroll
            for (int db = 0; db < 2; ++db)
#pragma unroll
                for (int r = 0; r < 16; ++r) F.out[O_C + (sbase * 64 + 32 * db + crow(r, hi)) * 128 + sl * 32 + r32] = Cacc[db][r];
        } else if (r32 == 0) {
#pragma unroll
            for (int db = 0; db < 2; ++db)
#pragma unroll
                for (int r = 0; r < 16; ++r) F.out[O_N + sbase * 64 + 32 * db + crow(r, hi)] = Cacc[db][r];
            if (lane == 0) F.out[O_M + sbase] = m;
        }
    }
}
constexpr int NLAT_TASKS = LB * 2 * HM * 5 * ML_NSEG;
constexpr int NLAT_GROUPS = NLAT_TASKS / 8, NCTX_GROUPS = (CB * 2 * HM * 5) / 8;
constexpr int NPRE_GROUPS = (LB * 2 * HM * 5 * (ML_NSEG - 1)) / 8;
__device__ __forceinline__ void task_group_lat(Frame& F, int l, int grp) {
    const int task = grp * 8 + F.wave, seg = task / 80, rem = task - seg * 80, stream = rem / 5, sl = rem - stream * 5;
    wave_task<false>(F, l, CB + (stream >> 3), (stream >> 2) & 1, stream & 3, sl, seg);
    __syncthreads();
}
__device__ __forceinline__ void task_group_pre(Frame& F, int l, int grp) {
    const int task = grp * 8 + F.wave, seg = task / 80, rem = task - seg * 80, stream = rem / 5, sl = rem - stream * 5;
    wave_task<true>(F, l, CB + (stream >> 3), (stream >> 2) & 1, stream & 3, sl, seg);
    __syncthreads();
}
__device__ __forceinline__ void task_group_ctx(Frame& F, int l, int grp) {
    const int task = grp * 8 + F.wave, stream = task / 5, sl = task - stream * 5;
    wave_task<false>(F, l, stream >> 3, (stream >> 2) & 1, stream & 3, sl, 0);
    __syncthreads();
}
}

constexpr int NDIFF_UNITS = 192, NMLA_UNITS = 384;
__device__ __forceinline__ void attn_unit_mla(Frame& F, int l, int item) {
    using namespace fa;
    const int tid = F.tid, wid = tid >> 6, lane = tid & 63, r32 = lane & 31, hi = lane >> 5;
    bool lat; int b, h, qb;
    if (item < 256) { lat = true; b = item >> 7; h = (item >> 4) & 7; qb = item & 15; }
    else { const int i = item - 256; lat = false; b = i >> 3; h = i & 7; qb = 0; }
    const int row0 = lat ? NCTX + b * LS + qb * 256 : b * CS;
    const int key0 = lat ? NCTX + b * LT : b * CS; const int T = lat ? LT : CS;
    typedef Geo<QKA, VA> G; LAS float* wsf = (LAS float*)(F.lds + G::OFF_WS) + wid * 64;
    const unsigned kv0 = (unsigned)WS_KV + ((unsigned)key0 * KVP + h * 128) * 2u;
    Src S{F.wsp<bf16_t>(WS_QA) + (size_t)row0 * 768 + h * QKA, 768, F.ws, kv0, (unsigned)WS_KV + ((unsigned)key0 * KVP + 1024) * 2u, kv0 + 128u, NOPE / 8, KVP, T};
    f32x16 o[2]; float lsum;
    attn_pass<QKA, VA>(S, F.lds, tid, 0.10206207261596577f * 1.4426950408889634f, o, lsum);
    normalize<2>(o, lsum, wsf, r32, hi, 1.f);
    bf16_t* O = F.wsp<bf16_t>(WS_OA) + (size_t)(row0 + wid * 32) * 512 + h * 64 + r32;
#pragma unroll
    for (int r = 0; r < 16; ++r) { const int orow = crow(r, hi);
#pragma unroll
        for (int d = 0; d < 2; ++d) O[(size_t)orow * 512 + d * 32] = (bf16_t)f2bf(o[d][r]); }
    { asm volatile("s_waitcnt lgkmcnt(0)" ::: "memory"); __builtin_amdgcn_s_barrier(); asm volatile("" ::: "memory"); }
}
__device__ __forceinline__ void attn_unit_diff(Frame& F, int l, int item) {
    using namespace fa;
    const int tid = F.tid, wid = tid >> 6, lane = tid & 63, r32 = lane & 31, hi = lane >> 5;
    bool lat; int b, h, qb;
    if (item < 128) { lat = true; b = item >> 6; h = (item >> 4) & 3; qb = item & 15; }
    else { const int i = item - 128; lat = false; b = i >> 2; h = i & 3; qb = 0; }
    const int row0 = lat ? NCTX + b * LS + qb * 256 : b * CS;
    const int key0 = lat ? NCTX + b * LT : b * CS; const int T = lat ? LT : CS;
    typedef Geo<DKD, DVD> G; LAS float* wsf = (LAS float*)(F.lds + G::OFF_WS) + wid * 64; LAS float* red = (LAS float*)(F.lds + G::OFF_RED) + wid * 32 * 33;
    const float lam = F.smallf()[SM_LAM + l * 2], lam_init = F.smallf()[SM_LAM + l * 2 + 1];
    bf16_t* DQp = F.wsp<bf16_t>(WS_DQ) + (size_t)row0 * 512 + h * 128;
    f32x16 o2[4]; float lsum;
    bf16_t* Stash = F.wsp<bf16_t>(WS_OM) + (size_t)(row0 + wid * 32) * 512 + h * 128 + r32;
    { Src S{DQp, 512, F.ws, (unsigned)WS_DK + ((unsigned)key0 * 512 + h * 128) * 2u, 0u, (unsigned)WS_DV + ((unsigned)key0 * 512 + h * 128) * 2u, 8, 512, T};
      attn_pass<DKD, DVD>(S, F.lds, tid, 0.125f * 1.4426950408889634f, o2, lsum); normalize<4>(o2, lsum, wsf, r32, hi, 1.f);
#pragma unroll
      for (int r = 0; r < 16; ++r) { const int orow = crow(r, hi);
#pragma unroll
          for (int d = 0; d < 4; ++d) Stash[(size_t)orow * 512 + d * 32] = (bf16_t)f2bf(o2[d][r]); } }
    { Src S{DQp + 64, 512, F.ws, (unsigned)WS_DK + ((unsigned)key0 * 512 + h * 128 + 64) * 2u, 0u, (unsigned)WS_DV + ((unsigned)key0 * 512 + h * 128) * 2u, 8, 512, T};
      attn_pass<DKD, DVD>(S, F.lds, tid, 0.125f * 1.4426950408889634f, o2, lsum); normalize<4>(o2, lsum, wsf, r32, hi, lam); }
#pragma unroll
    for (int rh = 0; rh < 16; rh += 4) { unsigned sv_[4][4];
#pragma unroll
      for (int r = 0; r < 4; ++r)
#pragma unroll
          for (int d = 0; d < 4; ++d) sv_[r][d] = Stash[(size_t)crow(rh + r, hi) * 512 + d * 32];
#pragma unroll
      for (int r = 0; r < 4; ++r) { float ss = 0.f; const int orow = crow(rh + r, hi);
#pragma unroll
          for (int d = 0; d < 4; ++d) { o2[d][rh + r] = bf2f((bf16_t)sv_[r][d]) - o2[d][rh + r]; ss += o2[d][rh + r] * o2[d][rh + r]; }
          red[orow * 33 + r32] = ss; }
      asm volatile("" ::: "memory"); }
    asm volatile("s_waitcnt lgkmcnt(0)" ::: "memory");
    float tot = 0.f;
#pragma unroll
    for (int c = 0; c < 16; ++c) tot += red[r32 * 33 + hi * 16 + c];
    { auto rr = __builtin_amdgcn_permlane32_swap(__float_as_uint(tot), __float_as_uint(tot), false, false); tot = __uint_as_float(rr[0]) + __uint_as_float(rr[1]); }
    if (hi == 0) wsf[r32] = rsqrtf(tot * (1.f / DVD) + EPS) * (1.f - lam_init);
    asm volatile("s_waitcnt lgkmcnt(0)" ::: "memory");
    const float* g = F.inp(I_DNG) + l * 512 + h * 128 + r32; float gv[4];
#pragma unroll
    for (int d = 0; d < 4; ++d) gv[d] = g[d * 32];
    bf16_t* O = DQp + (size_t)(wid * 32) * 512 + r32;
#pragma unroll
    for (int r = 0; r < 16; ++r) { const int orow = crow(r, hi); const float rs = wsf[orow];
#pragma unroll
        for (int d = 0; d < 4; ++d) O[(size_t)orow * 512 + d * 32] = (bf16_t)f2bf(o2[d][r] * rs * gv[d]); }
    { asm volatile("s_waitcnt lgkmcnt(0)" ::: "memory"); __builtin_amdgcn_s_barrier(); asm volatile("" ::: "memory"); }
}
#define LDS_BAR() do { asm volatile("s_waitcnt lgkmcnt(0)" ::: "memory"); __builtin_amdgcn_s_barrier(); asm volatile("" ::: "memory"); } while (0)
#define QUEUE_LOOP(QI, NITEMS, CALL) for (;;) { \
        if (F.tid == 0) *slot = (int)__hip_atomic_fetch_add((unsigned*)(F.ws + WS_CTL) + CW_QUEUE + (l * 8 + (QI)) * 64, 1u, __ATOMIC_RELAXED, __HIP_MEMORY_SCOPE_AGENT); \
        LDS_BAR(); const int item = *slot; LDS_BAR(); if (item >= (NITEMS)) break; asm volatile("" : "+v"(F.tid), "+v"(F.lane)); CALL; }
__device__ __forceinline__ void phase_attn(Frame& F, int l) {
    volatile LAS int* slot = (volatile LAS int*)(F.lds + MISC_OFF) + 16;
#ifndef USE_MLSTM_REF
    QUEUE_LOOP(0, ml::NLAT_GROUPS, ml::task_group_lat(F, l, item))
#endif
#ifndef NO_ATTN
    QUEUE_LOOP(1, NDIFF_UNITS, attn_unit_diff(F, l, item))
    QUEUE_LOOP(2, NMLA_UNITS, attn_unit_mla(F, l, item))
#endif
#ifndef USE_MLSTM_REF
    QUEUE_LOOP(3, ml::NCTX_GROUPS, ml::task_group_ctx(F, l, item))
#endif
    QUEUE_LOOP(5, CONV_CHUNKS, convert_late_chunk(F, l, item))
}

__device__ __forceinline__ void phase_om(Frame& F, int l, int wi, int nw) {
    const int gw = wi * NWAVES + F.wave, NGW = nw * NWAVES; const int lane = F.lane, head = lane >> 4, c = lane * 8;
    float g[8];
    { const f32x4 g0 = *(const f32x4*)(F.inp(I_MNG) + l * 512 + c), g1 = *(const f32x4*)(F.inp(I_MNG) + l * 512 + c + 4);
#pragma unroll
      for (int e = 0; e < 4; ++e) { g[e] = g0[e]; g[4 + e] = g1[e]; } }
    constexpr int NB = 4;
    for (int row0 = gw; row0 < M; row0 += NGW * NB) {
        u32x4 fw[NB], bw[NB], mw[NB]; float df[NB], db[NB];
#pragma unroll
        for (int i = 0; i < NB; ++i) { const size_t row = (size_t)min(row0 + i * NGW, M - 1);
            fw[i] = *(const u32x4*)(F.wsp<bf16_t>(WS_HF) + row * 512 + c); bw[i] = *(const u32x4*)(F.wsp<bf16_t>(WS_HB) + row * 512 + c);
            mw[i] = *(const u32x4*)(F.wsp<bf16_t>(WS_MQKVO) + row * 1536 + 1024 + c);
            const float* dn = F.wsp<float>(WS_DEN) + row * 8; df[i] = dn[head]; db[i] = dn[4 + head]; }
#pragma unroll
        for (int i = 0; i < NB; ++i) { const int row = row0 + i * NGW; const float rf = 1.f / df[i], rb = 1.f / db[i];
            float hf[8], hb[8], m8[8], h[8];
            UNPACK8(hf, 0, fw[i]); UNPACK8(hb, 0, bw[i]); UNPACK8(m8, 0, mw[i]);
            float ss = 0.f;
#pragma unroll
            for (int e = 0; e < 8; ++e) { h[e] = hf[e] * rf + hb[e] * rb; ss += h[e] * h[e]; }
            ss += lane_xor(ss, 1, lane); ss += lane_xor(ss, 2, lane); ss += lane_xor(ss, 4, lane); ss += lane_xor(ss, 8, lane);
            const float rs = rsqrtf(ss * (1.f / DVM) + EPS);
#pragma unroll
            for (int e = 0; e < 8; ++e) h[e] = h[e] * rs * g[e] * sigmoidf_(m8[e]);
            u32x4 w; w.x = pk2(h[0], h[1]); w.y = pk2(h[2], h[3]); w.z = pk2(h[4], h[5]); w.w = pk2(h[6], h[7]);
            if (row < M) *(u32x4*)(F.wsp<bf16_t>(WS_OM) + (size_t)row * 512 + c) = w; }
    }
}
__device__ __forceinline__ void phase_norm2(Frame& F, int l) {
    const int gw = F.bid * NWAVES + F.wave, NGW = F.G * NWAVES;
    for (int row = gw; row < M; row += NGW * 3) rmsmod_rows<false, 3>(F, l, row, NGW, F.inp(I_N2G) + l * D, 4, 3);
}
__device__ __forceinline__ void phase_final(Frame& F) {
    const int gw = F.bid * NWAVES + F.wave, NGW = F.G * NWAVES; const float* g = F.inp(I_FNG);
    constexpr int NB = 6;
    f32x4 gg[4];
#pragma unroll
    for (int j = 0; j < 4; ++j) gg[j] = *(const f32x4*)(g + 4 * F.lane + 256 * j);
    for (int row0 = gw; row0 < M; row0 += NGW * NB) { u32x2 xw[NB][4];
#pragma unroll
        for (int i = 0; i < NB; ++i) { const bf16_t* x = F.wsp<bf16_t>(WS_H) + (size_t)min(row0 + i * NGW, M - 1) * D;
#pragma unroll
            for (int j = 0; j < 4; ++j) xw[i][j] = *(const u32x2*)(x + 4 * F.lane + 256 * j); }
#pragma unroll
        for (int i = 0; i < NB; ++i) { const int row = row0 + i * NGW; f32x4 v[4]; float s = 0.f;
#pragma unroll
            for (int j = 0; j < 4; ++j) { const u32x2 w = xw[i][j]; v[j] = (f32x4){lo_bf(w.x), hi_bf(w.x), lo_bf(w.y), hi_bf(w.y)}; s += (v[j][0] * v[j][0] + v[j][1] * v[j][1]) + (v[j][2] * v[j][2] + v[j][3] * v[j][3]); }
            const float r = rsqrtf(wave_sum(s, F.lane) * (1.f / D) + EPS);
            if (row < M) { float* y = F.out + O_X + (size_t)row * D;
#pragma unroll
                for (int j = 0; j < 4; ++j) *(f32x4*)(y + 4 * F.lane + 256 * j) = v[j] * r * gg[j]; } } }
}

#ifdef USE_GEMM_REF
#define GEMM_PHASE gemm_ref
#else
#define GEMM_PHASE pg8::gemm_phase<4>
#define GEMM_PHASE3 pg8::gemm_phase<3>
#endif
constexpr int PH_PER_LAYER = 10, N_PHASES = 1 + DEPTH * PH_PER_LAYER + 1;
__global__ void __launch_bounds__(NTHR, 2) mega_fwd(Args args) {
    extern __shared__ __attribute__((aligned(16))) unsigned char lds_raw[];
    Frame F; F.lds = (LAS unsigned char*)lds_raw; F.tid = threadIdx.x; F.lane = F.tid & 63; F.wave = __builtin_amdgcn_readfirstlane(F.tid >> 6);
    F.G = gridDim.x; F.bid = blockIdx.x; F.out = opaque_ptr(args.out); F.ws = opaque_ptr(args.ws);
    F.ka = (const __attribute__((address_space(4))) Args*)__builtin_amdgcn_kernarg_segment_ptr();
    for (int u = F.tid; u < (LDS_BYTES - LDSCTL_OFF) / 4; u += NTHR) ((LAS unsigned*)(F.lds + LDSCTL_OFF))[u] = 0u;
    __syncthreads();
    XcdBarrier bar = xcd_barrier_post((unsigned*)(F.ws + WS_CTL) + CW_BAR + args.li * XCD_BAR_WORDS, (volatile LAS unsigned*)(F.lds + MISC_OFF) + 8);
    const int lo = args.ph_lo, hi = args.ph_hi;
#ifndef PHMASK
#define PHMASK 0xFFFFFFFFu
#endif
#define PHBIT(k) ((k) == 0 ? 0 : (k) == N_PHASES - 1 ? 11 : (((k) - 1) % PH_PER_LAYER) + 1)
#define IN(k) (((PHMASK >> PHBIT(k)) & 1u) && lo <= (k) && (k) < hi)
#define SEAM(k) do { if (IN(k) && IN((k) + 1)) xcd_barrier(bar); asm volatile("" : "+v"(F.tid), "+v"(F.lane)); F.ws = opaque_ptr(F.ws); F.out = opaque_ptr(F.out); F.G = opaque_int(F.G); F.bid = opaque_int(F.bid); } while (0)
    if (IN(0)) { phase_mod(F); convert_set<0>(F, 0, F.bid * NWAVES + F.wave, F.G * NWAVES); } SEAM(0);
#pragma unroll 1
    for (int l = 0; l < DEPTH; ++l) {
        const int pb = 1 + l * PH_PER_LAYER;
        float* ssq = (float*)(F.ws + WS_CTL) + CW_SSQ + l * M; float* sskv = (float*)(F.ws + WS_CTL) + CW_SSKV + l * M;
        if (IN(pb + 0)) { phase_layer_prep(F, l); } SEAM(pb + 0);
        if (IN(pb + 1)) {
            ProbSimple P{F.wsp<bf16_t>(WS_H), F.wsp<bf16_t>(WS_WIN), D}; TileOrder S; S.init(M / BM, ZN / BM, F.G, F.bid);
            EpiZ E{l, F.ws, F.out, F.inp(I_GATEB)};
            GEMM_PHASE(F.lds, F.tid, P, S, E);
        } SEAM(pb + 1);
        if (IN(pb + 2)) {
            { ProbSimple P{F.wsp<bf16_t>(WS_ACQ), F.wsp<bf16_t>(WS_WQ), QR}; TileOrder S; S.init(M / BM, 768 / BM, F.G, F.bid);
              EpiQ E{F.wsp<bf16_t>(WS_QA), ssq, F.smallf() + SM_TA}; GEMM_PHASE(F.lds, F.tid, P, S, E); }
            { ProbSimple P{F.wsp<bf16_t>(WS_ACKV), F.wsp<bf16_t>(WS_WKVG), KVR}; TileOrder S; S.init(M / BM, 1024 / BM, F.G, (F.bid + 144) % F.G);
              EpiKV E{F.wsp<bf16_t>(WS_KV), sskv, 0}; GEMM_PHASE(F.lds, F.tid, P, S, E); }
            { ProbSimple P{F.wsp<bf16_t>(WS_CKVC), F.wsp<bf16_t>(WS_WKV), KVR}; TileOrder S; S.init(LB * PAST / BM, 1024 / BM, F.G, (F.bid + 80) % F.G);
              EpiKV E{F.wsp<bf16_t>(WS_KV), sskv, 1}; GEMM_PHASE(F.lds, F.tid, P, S, E); }
            phase_ckv_out(F, l);
            { volatile LAS int* slot = (volatile LAS int*)(F.lds + MISC_OFF) + 16; QUEUE_LOOP(4, ml::NPRE_GROUPS, ml::task_group_pre(F, l, item)) }
        } SEAM(pb + 2);
        if (IN(pb + 3)) {
#ifdef USE_MLSTM_REF
            mlstm_ref(F, l);
#endif
            phase_attn(F, l);
        } SEAM(pb + 3);
        if (IN(pb + 4)) {
            ProbSimple P{F.wsp<bf16_t>(WS_H), F.wsp<bf16_t>(WS_WIN) + (size_t)ZN * D, D}; TileOrder S; S.init(M / BM, GN / BM, F.G, F.bid);
            EpiGate E{F.wsp<bf16_t>(WS_GATES)}; GEMM_PHASE(F.lds, F.tid, P, S, E);
            { const int nwg = (M / BM) * (GN / BM), r = nwg % F.G, nw = r == 0 ? F.G : F.G - r, wi = r == 0 ? F.bid : F.bid - r; if (wi >= 0) phase_om(F, l, wi, nw); }
        } SEAM(pb + 4);
        if (IN(pb + 5)) {
            ProbBranchT<3> P{F.ws, 512};
            TileOrder S; S.init(M / 192, D / BM, F.G, F.bid, 3);
            EpiBranchT<3> E{F.wsp<bf16_t>(WS_H), F.wsp<bf16_t>(WS_GATES)}; GEMM_PHASE3(F.lds, F.tid, P, S, E);
        } SEAM(pb + 5);
        if (IN(pb + 6)) {
            ProbSimpleT<3> P{F.wsp<bf16_t>(WS_H), F.wsp<bf16_t>(WS_WOUT), D}; TileOrder S; S.init(M / 192, D / BM, F.G, F.bid);
            EpiResidT<3> E{F.inp(I_XP), F.inp(I_XS), l == 0, F.x16(), F.x16(), F.mod(l, 0, 2)}; GEMM_PHASE3(F.lds, F.tid, P, S, E);
        } SEAM(pb + 6);
        if (IN(pb + 7)) { phase_norm2(F, l); } SEAM(pb + 7);
        if (IN(pb + 8)) {
            ProbSimple P{F.wsp<bf16_t>(WS_H), F.wsp<bf16_t>(WS_W1), D}; TileOrder S; S.init(M / BM, DFF / BM, F.G, F.bid);
            EpiRelu2 E{F.wsp<bf16_t>(WS_U)}; GEMM_PHASE(F.lds, F.tid, P, S, E);
        } SEAM(pb + 8);
        if (IN(pb + 9)) {
            if (l + 1 < DEPTH) {
                ProbSimple P{F.wsp<bf16_t>(WS_U), F.wsp<bf16_t>(WS_W2), DFF}; TileOrder S; S.init(M / BM, D / BM, F.G, F.bid);
                EpiResidT<4> E{nullptr, nullptr, 0, F.x16(), F.x16(), F.mod(l, 0, 5)}; GEMM_PHASE(F.lds, F.tid, P, S, E);
                convert_on_idle<0>(F, l + 1, (M / BM) * (D / BM));
            } else {
                ProbSimpleT<3> P{F.wsp<bf16_t>(WS_U), F.wsp<bf16_t>(WS_W2), DFF}; TileOrder S; S.init(M / 192, D / BM, F.G, F.bid);
                EpiResidT<3> E{nullptr, nullptr, 0, F.x16(), F.wsp<bf16_t>(WS_H), F.mod(l, 0, 5)}; GEMM_PHASE3(F.lds, F.tid, P, S, E);
            }
        } SEAM(pb + 9);
    }
    if (IN(N_PHASES - 1)) phase_final(F);
#undef IN
#undef SEAM
}

extern "C" void kernel_launch(void* const* d_in, const int* in_sizes, int n_in, void* d_out, int out_size, void* d_ws, size_t ws_size, hipStream_t stream) {
    static int grid = 0;
    if (grid == 0) {
        if (n_in != 31 || (size_t)out_size != O_END || ws_size < WS_END) { fprintf(stderr, "kernel_launch: unexpected shapes n_in %d out %d ws %zu\n", n_in, out_size, ws_size); grid = -1; return; }
        int dev = 0, cus = 0, per_cu = 0;
        if (hipGetDevice(&dev) != hipSuccess || hipDeviceGetAttribute(&cus, hipDeviceAttributeMultiprocessorCount, dev) != hipSuccess) { grid = -1; return; }
        if (hipFuncSetAttribute((const void*)mega_fwd, hipFuncAttributeMaxDynamicSharedMemorySize, LDS_BYTES) != hipSuccess) { fprintf(stderr, "kernel_launch: LDS attribute failed\n"); grid = -1; return; }
        if (hipOccupancyMaxActiveBlocksPerMultiprocessor(&per_cu, (const void*)mega_fwd, NTHR, LDS_BYTES) != hipSuccess || per_cu < 1) { fprintf(stderr, "kernel_launch: occupancy query says %d blocks/CU\n", per_cu); (void)hipGetLastError(); grid = -1; return; }
        grid = cus;
    }
    if (grid < 0) return;
    (void)hipMemsetAsync((char*)d_ws + WS_CTL, 0, CTL_BYTES, stream);
    Args a{};
    for (int i = 0; i < 31; ++i) a.in[i] = (const float*)d_in[i];
    a.out = (float*)d_out; a.ws = (unsigned char*)d_ws; a.ph_lo = 0; a.ph_hi = N_PHASES; a.li = 0; a.pad = 0;
    hipLaunchKernelGGL(mega_fwd, dim3(grid), dim3(NTHR), LDS_BYTES, stream, a);
}
```
